# Optimizing an MI355X kernel written in HIP

```python
import math
import jax, jax.numpy as jnp
from jax import lax
import numpy as np

D_MODEL = 1024
BATCH = 8
SEQ = 2048
DEPTH = 4

N_MIXERS = 3
N_ATTN_LAYERS = len(range(0, DEPTH, N_MIXERS))
N_CONV_LAYERS = len(range(1, DEPTH, N_MIXERS))
N_SGU_LAYERS = len(range(2, DEPTH, N_MIXERS))

ATTN_HEADS = 8
ATTN_HEAD_DIM = D_MODEL // (2 * ATTN_HEADS)
Q_BLOCK = 128
REL_BUCKETS = 32
REL_MAX_DIST = 128
CONV_WIDTH = 3
SGU_CHUNK = 128
SGU_GROUPS = 8
SGU_GROUP_DIM = D_MODEL // SGU_GROUPS
PEER_HEADS = 8
PEER_NKEYS = 128
PEER_EXPERTS = PEER_NKEYS * PEER_NKEYS
PEER_KEY_DIM = 256
PEER_HALF = PEER_KEY_DIM // 2
PEER_TOPK = 16
PEER_TOKEN_BLOCK = 128
EPS = 1e-6

kernel_name = "hybrid_diffattn_shortconv_gmlp_peer"

F32 = jnp.float32


def rmsnorm(x, g):
    xf = x.astype(F32)
    y = xf * lax.rsqrt(jnp.mean(xf * xf, axis=-1, keepdims=True) + EPS)
    return (y * g.astype(F32)).astype(x.dtype)


def rel_bucket(dist):
    n = jnp.maximum(dist, 0)
    max_exact = REL_BUCKETS // 2
    nf = jnp.maximum(n, 1).astype(F32)
    large = max_exact + (jnp.log(nf / max_exact) / math.log(REL_MAX_DIST / max_exact)
                         * (REL_BUCKETS - max_exact)).astype(jnp.int32)
    large = jnp.minimum(large, REL_BUCKETS - 1)
    return jnp.where(n < max_exact, n, large)


def lambda_init_fn(layer_idx):
    return 0.8 - 0.6 * math.exp(-0.3 * layer_idx)


def diff_attention(h, w_qkv, q_gain, k_gain, lam_q1, lam_k1, lam_q2, lam_k2, sub_gain, w_o,
                   rel_bias, lam_init):
    B, S, D = h.shape
    H, DH = ATTN_HEADS, ATTN_HEAD_DIM
    qkv = h @ w_qkv
    q = rmsnorm(qkv[..., :D].reshape(B, S, H, 2, DH), q_gain)
    k = rmsnorm(qkv[..., D:2 * D].reshape(B, S, H, 2, DH), k_gain)
    v = qkv[..., 2 * D:].reshape(B, S, H, 2 * DH)
    lam = (jnp.exp(jnp.sum(lam_q1.astype(F32) * lam_k1.astype(F32)))
           - jnp.exp(jnp.sum(lam_q2.astype(F32) * lam_k2.astype(F32))) + lam_init)
    scale = DH ** -0.5
    pos = jnp.arange(S, dtype=jnp.int32)
    outs = []
    for blk in range(S // Q_BLOCK):
        start = blk * Q_BLOCK
        end = start + Q_BLOCK
        dist = pos[start:end, None] - pos[None, :end]
        bias = jnp.transpose(rel_bias[rel_bucket(dist)], (2, 0, 1)).astype(F32)
        logits = (jnp.einsum('bqhmd,bkhmd->bhmqk', q[:, start:end], k[:, :end]).astype(F32) * scale
                  + bias[None, :, None])
        logits = jnp.where(dist >= 0, logits, -jnp.inf)
        p = jax.nn.softmax(logits, axis=-1)
        attn = (p[:, :, 0] - lam * p[:, :, 1]).astype(v.dtype)
        outs.append(jnp.einsum('bhqk,bkhe->bqhe', attn, v[:, :end]))
    o = jnp.concatenate(outs, axis=1)
    o = rmsnorm(o, sub_gain) * (1.0 - lam_init)
    return o.reshape(B, S, D) @ w_o


def short_conv(h, w_in, conv_w, w_out):
    D = h.shape[-1]
    bcx = h @ w_in
    b_gate, c_gate, xin = bcx[..., :D], bcx[..., D:2 * D], bcx[..., 2 * D:]
    z = c_gate * xin
    zc = lax.conv_general_dilated(z, conv_w[:, None, :].astype(z.dtype), window_strides=(1,),
                                  padding=[(CONV_WIDTH - 1, 0)],
                                  dimension_numbers=('NWC', 'WIO', 'NWC'),
                                  feature_group_count=D)
    return (b_gate * zc) @ w_out


def spatial_gating_mlp(h, w_in, v_gain, w_s, b_s, w_out):
    B, S, D = h.shape
    z = jax.nn.gelu(h @ w_in)
    u, v = z[..., :D], rmsnorm(z[..., D:], v_gain)
    v = v.reshape(B, S // SGU_CHUNK, SGU_CHUNK, SGU_GROUPS, SGU_GROUP_DIM)
    mask = jnp.tril(jnp.ones((SGU_CHUNK, SGU_CHUNK), dtype=bool))
    w = jnp.where(mask[None], w_s, 0.0).astype(v.dtype)
    sv = (jnp.einsum('gts,bnsgc->bntgc', w, v)
          + jnp.transpose(b_s, (1, 0))[None, None, :, :, None])
    return (u * sv.reshape(B, S, D)) @ w_out


def peer_ffn(h, w_q, sub_keys, u_tab, v_tab):
    B, S, D = h.shape
    T = B * S
    xt = h.reshape(T, D)
    q = (xt @ w_q).reshape(T, PEER_HEADS, 2, PEER_HALF)
    s = jnp.einsum('thpd,hpkd->thpk', q, sub_keys).astype(F32)
    s_top, i_top = lax.top_k(s, PEER_TOPK)
    cand = (s_top[:, :, 0, :, None] + s_top[:, :, 1, None, :]).reshape(T, PEER_HEADS, -1)
    cand_idx = (i_top[:, :, 0, :, None] * PEER_NKEYS + i_top[:, :, 1, None, :]).reshape(T, PEER_HEADS, -1)
    best, pos = lax.top_k(cand, PEER_TOPK)
    idx = jnp.take_along_axis(cand_idx, pos, axis=-1)
    gates = jax.nn.softmax(best, axis=-1)

    def expert_block(args):
        xb, ib, gb = args
        act = jnp.einsum('chkd,cd->chk', u_tab[ib], xb)
        act = (jax.nn.gelu(act.astype(F32)) * gb).astype(xb.dtype)
        return jnp.einsum('chk,chkd->cd', act, v_tab[ib])

    nb = T // PEER_TOKEN_BLOCK
    out = lax.map(expert_block, (xt.reshape(nb, PEER_TOKEN_BLOCK, D),
                                 idx.reshape(nb, PEER_TOKEN_BLOCK, PEER_HEADS, PEER_TOPK),
                                 gates.reshape(nb, PEER_TOKEN_BLOCK, PEER_HEADS, PEER_TOPK)))
    return out.reshape(B, S, D)


def setup_inputs(seed: int = 0) -> dict:
    key = jax.random.key(seed)
    ks = iter(jax.random.split(key, 32))
    D = D_MODEL
    NA, NC, NS = N_ATTN_LAYERS, N_CONV_LAYERS, N_SGU_LAYERS
    DH = ATTN_HEAD_DIM

    def nrm(shape, scale):
        return jax.random.normal(next(ks), shape, F32) * scale

    return {
        "x": nrm((BATCH, SEQ, D), 1.0),
        "rel_bias": nrm((REL_BUCKETS, ATTN_HEADS), 0.5),
        "norm_mix": 1.0 + nrm((DEPTH, D), 0.02),
        "norm_ffn": 1.0 + nrm((DEPTH, D), 0.02),
        "attn_w_qkv": nrm((NA, D, 3 * D), D ** -0.5),
        "attn_q_gain": 1.0 + nrm((NA, DH), 0.02),
        "attn_k_gain": 1.0 + nrm((NA, DH), 0.02),
        "attn_lam_q1": nrm((NA, DH), 0.1),
        "attn_lam_k1": nrm((NA, DH), 0.1),
        "attn_lam_q2": nrm((NA, DH), 0.1),
        "attn_lam_k2": nrm((NA, DH), 0.1),
        "attn_sub_gain": 1.0 + nrm((NA, 2 * DH), 0.02),
        "attn_w_o": nrm((NA, D, D), D ** -0.5),
        "conv_w_in": nrm((NC, D, 3 * D), D ** -0.5),
        "conv_w": nrm((NC, CONV_WIDTH, D), CONV_WIDTH ** -0.5),
        "conv_w_out": nrm((NC, D, D), D ** -0.5),
        "sgu_w_in": nrm((NS, D, 2 * D), D ** -0.5),
        "sgu_v_gain": 1.0 + nrm((NS, D), 0.02),
        "sgu_w_s": nrm((NS, SGU_GROUPS, SGU_CHUNK, SGU_CHUNK), SGU_CHUNK ** -0.5),
        "sgu_b_s": 1.0 + nrm((NS, SGU_GROUPS, SGU_CHUNK), 0.02),
        "sgu_w_out": nrm((NS, D, D), D ** -0.5),
        "peer_w_q": nrm((DEPTH, D, PEER_HEADS * PEER_KEY_DIM), D ** -0.5),
        "peer_keys": nrm((DEPTH, PEER_HEADS, 2, PEER_NKEYS, PEER_HALF), PEER_HALF ** -0.5),
        "peer_u": nrm((DEPTH, PEER_EXPERTS, D), D ** -0.5),
        "peer_v": nrm((DEPTH, PEER_EXPERTS, D), 0.25),
    }


def reference(x, rel_bias, norm_mix, norm_ffn,
              attn_w_qkv, attn_q_gain, attn_k_gain, attn_lam_q1, attn_lam_k1, attn_lam_q2,
              attn_lam_k2, attn_sub_gain, attn_w_o,
              conv_w_in, conv_w, conv_w_out,
              sgu_w_in, sgu_v_gain, sgu_w_s, sgu_b_s, sgu_w_out,
              peer_w_q, peer_keys, peer_u, peer_v):
    h = x
    for i in range(DEPTH):
        m, j = i % N_MIXERS, i // N_MIXERS
        hn = rmsnorm(h, norm_mix[i])
        if m == 0:
            y = diff_attention(hn, attn_w_qkv[j], attn_q_gain[j], attn_k_gain[j],
                               attn_lam_q1[j], attn_lam_k1[j], attn_lam_q2[j], attn_lam_k2[j],
                               attn_sub_gain[j], attn_w_o[j], rel_bias, lambda_init_fn(i))
        elif m == 1:
            y = short_conv(hn, conv_w_in[j], conv_w[j], conv_w_out[j])
        else:
            y = spatial_gating_mlp(hn, sgu_w_in[j], sgu_v_gain[j], sgu_w_s[j], sgu_b_s[j],
                                   sgu_w_out[j])
        h = h + y
        h = h + peer_ffn(rmsnorm(h, norm_ffn[i]), peer_w_q[i], peer_keys[i], peer_u[i], peer_v[i])
    return h
```

```cpp
#include <hip/hip_runtime.h>
#include <cstdio>
#include <cstdint>
#include <cmath>

namespace nv {
constexpr int D = 1024, BATCH = 8, SEQ = 2048, T = BATCH * SEQ, DEPTH = 4;
constexpr int H = 8, DH = 64;
constexpr int PH = 8, NK = 128, PK = 16, NEXP = 16384;
constexpr float EPS = 1e-6f;
constexpr float LOG2E = 1.4426950408889634f;
constexpr float C2 = 0.125f * LOG2E;
typedef unsigned short bf16_t;

__device__ __forceinline__ float bf2f(bf16_t v) { return __uint_as_float(((unsigned)v) << 16); }
__device__ __forceinline__ bf16_t f2bf(float f) { unsigned u = __float_as_uint(f); return (bf16_t)((u + 0x7fffu + ((u >> 16) & 1u)) >> 16); }
__device__ __forceinline__ float wave_sum(float v) {
#pragma unroll
    for (int o = 1; o < 64; o <<= 1) v += __shfl_xor(v, o);
    return v;
}
__device__ __forceinline__ float wave_max(float v) {
#pragma unroll
    for (int o = 1; o < 64; o <<= 1) v = fmaxf(v, __shfl_xor(v, o));
    return v;
}
__device__ __forceinline__ float gelu_tanh(float x) {
    const float k0 = 0.7978845608028654f, k1 = 0.044715f;
    return 0.5f * x * (1.0f + tanhf(k0 * (x + k1 * x * x * x)));
}

__global__ __launch_bounds__(256) void k_rmsnorm(const float* __restrict__ h, const float* __restrict__ g, float* __restrict__ out) {
    const int row = blockIdx.x * 4 + (threadIdx.x >> 6), lane = threadIdx.x & 63;
    const float* x = h + (size_t)row * D;
    float v[16]; float ss = 0.f;
#pragma unroll
    for (int i = 0; i < 16; ++i) { v[i] = x[lane + 64 * i]; ss += v[i] * v[i]; }
    ss = wave_sum(ss);
    const float r = rsqrtf(ss * (1.0f / D) + EPS);
#pragma unroll
    for (int i = 0; i < 16; ++i) out[(size_t)row * D + lane + 64 * i] = v[i] * r * g[lane + 64 * i];
}

template <typename TA> __device__ __forceinline__ float ldA(const TA* p);
template <> __device__ __forceinline__ float ldA<float>(const float* p) { return *p; }
template <> __device__ __forceinline__ float ldA<bf16_t>(const bf16_t* p) { return bf2f(*p); }
template <typename TA, bool ACC>
__global__ __launch_bounds__(256) void k_sgemm(const TA* __restrict__ A, int lda, const float* __restrict__ W, int N, float* C, int ldc, int K) {
    __shared__ float As[16][132];
    __shared__ float Ws[16][132];
    const int tid = threadIdx.x, tx = tid & 15, ty = tid >> 4;
    const int bm = blockIdx.y * 128, bn = blockIdx.x * 128;
    float acc[8][8];
#pragma unroll
    for (int i = 0; i < 8; ++i)
#pragma unroll
        for (int j = 0; j < 8; ++j) acc[i][j] = 0.f;
    for (int k0 = 0; k0 < K; k0 += 16) {
#pragma unroll
        for (int i = 0; i < 8; ++i) { const int idx = tid + i * 256, r = idx >> 4, c = idx & 15; As[c][r] = ldA<TA>(A + (size_t)(bm + r) * lda + k0 + c); }
#pragma unroll
        for (int i = 0; i < 8; ++i) { const int idx = tid + i * 256, r = idx >> 7, c = idx & 127; Ws[r][c] = W[(size_t)(k0 + r) * N + bn + c]; }
        __syncthreads();
#pragma unroll
        for (int kk = 0; kk < 16; ++kk) {
            float a[8], b[8];
#pragma unroll
            for (int i = 0; i < 8; ++i) a[i] = As[kk][ty * 8 + i];
#pragma unroll
            for (int j = 0; j < 8; ++j) b[j] = Ws[kk][tx * 8 + j];
#pragma unroll
            for (int i = 0; i < 8; ++i)
#pragma unroll
                for (int j = 0; j < 8; ++j) acc[i][j] += a[i] * b[j];
        }
        __syncthreads();
    }
#pragma unroll
    for (int i = 0; i < 8; ++i)
#pragma unroll
        for (int j = 0; j < 8; ++j) { float* p = C + (size_t)(bm + ty * 8 + i) * ldc + bn + tx * 8 + j; *p = ACC ? (*p + acc[i][j]) : acc[i][j]; }
}

__global__ __launch_bounds__(256) void k_qkv_post(const float* __restrict__ qkv, const float* __restrict__ qg, const float* __restrict__ kg,
                                                  bf16_t* __restrict__ qb, bf16_t* __restrict__ kb, bf16_t* __restrict__ vb) {
    const int row = blockIdx.x * 4 + (threadIdx.x >> 6), lane = threadIdx.x & 63;
    const float* r = qkv + (size_t)row * 3072;
    for (int grp = 0; grp < 16; ++grp) {
        float q = r[grp * 64 + lane], k = r[1024 + grp * 64 + lane];
        float sq = wave_sum(q * q), sk = wave_sum(k * k);
        q = q * rsqrtf(sq * (1.f / 64) + EPS) * qg[lane] * C2;
        k = k * rsqrtf(sk * (1.f / 64) + EPS) * kg[lane];
        qb[(size_t)row * D + grp * 64 + lane] = f2bf(q);
        kb[(size_t)row * D + grp * 64 + lane] = f2bf(k);
    }
    for (int i = 0; i < 16; ++i) vb[(size_t)row * D + i * 64 + lane] = f2bf(r[2048 + i * 64 + lane]);
}

__device__ __forceinline__ int rel_bucket(int n) {
    if (n < 16) return n;
    const float nf = (float)n;
    int large = 16 + (int)(logf(nf / 16.0f) / 2.0794415416798357f * 16.0f);
    return large < 31 ? large : 31;
}

__global__ __launch_bounds__(256) void k_attn_naive(const bf16_t* __restrict__ qb, const bf16_t* __restrict__ kb, const bf16_t* __restrict__ vb,
                                                    const float* __restrict__ rel_bias, const float* __restrict__ lq1, const float* __restrict__ lk1,
                                                    const float* __restrict__ lq2, const float* __restrict__ lk2, const float* __restrict__ sub_gain,
                                                    float lam_init, bf16_t* __restrict__ on) {
    __shared__ float lg[4][2][SEQ];
    const int wid = threadIdx.x >> 6, lane = threadIdx.x & 63;
    const int gq = blockIdx.x * 4 + wid;
    const int q = gq % SEQ, h = (gq / SEQ) % H, b = gq / (SEQ * H);
    const float lam = expf(wave_sum(lq1[lane] * lk1[lane])) - expf(wave_sum(lq2[lane] * lk2[lane])) + lam_init;
    const size_t rowq = (size_t)(b * SEQ + q);
    float inv[2];
    for (int m = 0; m < 2; ++m) {
        float qv[64];
#pragma unroll
        for (int d = 0; d < 64; ++d) qv[d] = bf2f(qb[rowq * D + h * 128 + m * 64 + d]);
        float mx = -INFINITY;
        for (int j = lane; j <= q; j += 64) {
            const bf16_t* kr = kb + (size_t)(b * SEQ + j) * D + h * 128 + m * 64;
            float s = 0.f;
#pragma unroll
            for (int d = 0; d < 64; ++d) s += qv[d] * bf2f(kr[d]);
            s += rel_bias[rel_bucket(q - j) * H + h] * LOG2E;
            lg[wid][m][j] = s; mx = fmaxf(mx, s);
        }
        mx = wave_max(mx);
        float sum = 0.f;
        for (int j = lane; j <= q; j += 64) { const float p = exp2f(lg[wid][m][j] - mx); lg[wid][m][j] = p; sum += p; }
        sum = wave_sum(sum);
        inv[m] = 1.0f / sum;
    }
    __syncthreads();
    float o0 = 0.f, o1 = 0.f;
    for (int j = 0; j <= q; ++j) {
        const float a = lg[wid][0][j] * inv[0] - lam * lg[wid][1][j] * inv[1];
        const bf16_t* vr = vb + (size_t)(b * SEQ + j) * D + h * 128;
        o0 += a * bf2f(vr[lane]); o1 += a * bf2f(vr[lane + 64]);
    }
    const float ss = wave_sum(o0 * o0 + o1 * o1);
    const float r = rsqrtf(ss * (1.f / 128) + EPS) * (1.0f - lam_init);
    on[rowq * D + h * 128 + lane] = f2bf(o0 * r * sub_gain[lane]);
    on[rowq * D + h * 128 + lane + 64] = f2bf(o1 * r * sub_gain[lane + 64]);
}

__global__ __launch_bounds__(256) void k_conv_post(const float* __restrict__ bcx, const float* __restrict__ cw, bf16_t* __restrict__ a) {
    const size_t i = (size_t)blockIdx.x * 256 + threadIdx.x;
    const int d = (int)(i % D); const size_t row = i / D; const int t = (int)(row % SEQ);
    const float* r = bcx + row * 3072;
    float z0 = r[1024 + d] * r[2048 + d];
    float z1 = (t >= 1) ? (r - 3072)[1024 + d] * (r - 3072)[2048 + d] : 0.f;
    float z2 = (t >= 2) ? (r - 6144)[1024 + d] * (r - 6144)[2048 + d] : 0.f;
    const float zc = cw[0 * D + d] * z2 + cw[1 * D + d] * z1 + cw[2 * D + d] * z0;
    a[i] = f2bf(r[d] * zc);
}

__global__ __launch_bounds__(256) void k_sgu_post1(float* __restrict__ z, const float* __restrict__ vg) {
    const int row = blockIdx.x * 4 + (threadIdx.x >> 6), lane = threadIdx.x & 63;
    float* r = z + (size_t)row * 2048;
    float v[16]; float ss = 0.f;
#pragma unroll
    for (int i = 0; i < 16; ++i) { r[lane + 64 * i] = gelu_tanh(r[lane + 64 * i]); v[i] = gelu_tanh(r[1024 + lane + 64 * i]); ss += v[i] * v[i]; }
    ss = wave_sum(ss);
    const float rs = rsqrtf(ss * (1.f / D) + EPS);
#pragma unroll
    for (int i = 0; i < 16; ++i) r[1024 + lane + 64 * i] = v[i] * rs * vg[lane + 64 * i];
}
__global__ __launch_bounds__(256) void k_sgu_spatial(const float* __restrict__ z, const float* __restrict__ ws, const float* __restrict__ bs, bf16_t* __restrict__ a) {
    const size_t i = (size_t)blockIdx.x * 256 + threadIdx.x;
    const int d = (int)(i % D); const size_t row = i / D; const int tl = (int)(row % 128); const size_t row0 = row - tl; const int g = d / 128;
    float acc = 0.f;
    for (int s = 0; s <= tl; ++s) acc += ws[((size_t)g * 128 + tl) * 128 + s] * z[(row0 + s) * 2048 + 1024 + d];
    acc += bs[g * 128 + tl];
    a[i] = f2bf(z[row * 2048 + d] * acc);
}

__global__ __launch_bounds__(64) void k_peer_route(const float* __restrict__ q, const float* __restrict__ keys, int* __restrict__ idx, float* __restrict__ gate) {
    const int gi = blockIdx.x * 64 + threadIdx.x; const int t = gi >> 3, hp = gi & 7;
    float tv[2][16]; int ti[2][16];
#pragma unroll
    for (int p = 0; p < 2; ++p)
#pragma unroll
        for (int i = 0; i < 16; ++i) { tv[p][i] = -INFINITY; ti[p][i] = 0; }
#pragma unroll
    for (int p = 0; p < 2; ++p) {
        const float* qr = q + (size_t)t * 2048 + hp * 256 + p * 128;
        for (int k = 0; k < NK; ++k) {
            const float* kr = keys + ((size_t)(hp * 2 + p) * NK + k) * 128;
            float s = 0.f;
            for (int d = 0; d < 128; ++d) s += qr[d] * kr[d];
            float cv = s; int ci = k;
#pragma unroll
            for (int i = 0; i < 16; ++i) { const bool gt = cv > tv[p][i]; const float ov = tv[p][i]; const int oi = ti[p][i]; tv[p][i] = gt ? cv : ov; ti[p][i] = gt ? ci : oi; cv = gt ? ov : cv; ci = gt ? oi : ci; }
        }
    }
    float bv[16]; int bi[16];
#pragma unroll
    for (int i = 0; i < 16; ++i) { bv[i] = -INFINITY; bi[i] = 0; }
#pragma unroll
    for (int a = 0; a < 16; ++a)
#pragma unroll
        for (int b = 0; b < 16; ++b) {
            float cv = tv[0][a] + tv[1][b]; int ci = ti[0][a] * NK + ti[1][b];
#pragma unroll
            for (int i = 0; i < 16; ++i) { const bool gt = cv > bv[i]; const float ov = bv[i]; const int oi = bi[i]; bv[i] = gt ? cv : ov; bi[i] = gt ? ci : oi; cv = gt ? ov : cv; ci = gt ? oi : ci; }
        }
    float sum = 0.f; float e[16];
#pragma unroll
    for (int i = 0; i < 16; ++i) { e[i] = expf(bv[i] - bv[0]); sum += e[i]; }
    const float inv = 1.f / sum;
#pragma unroll
    for (int i = 0; i < 16; ++i) { idx[(size_t)t * 128 + hp * 16 + i] = bi[i]; gate[(size_t)t * 128 + hp * 16 + i] = e[i] * inv; }
}

__global__ __launch_bounds__(256) void k_peer_expert(const float* __restrict__ xn, const int* __restrict__ idx, const float* __restrict__ gate,
                                                     const float* __restrict__ ut, const float* __restrict__ vt, float* __restrict__ h) {
    const int t = blockIdx.x * 4 + (threadIdx.x >> 6), lane = threadIdx.x & 63;
    float x[16], o[16];
#pragma unroll
    for (int i = 0; i < 16; ++i) { x[i] = xn[(size_t)t * D + lane + 64 * i]; o[i] = 0.f; }
    for (int k = 0; k < 128; ++k) {
        const int e = idx[(size_t)t * 128 + k]; const float g = gate[(size_t)t * 128 + k];
        const float* ur = ut + (size_t)e * D; const float* vr = vt + (size_t)e * D;
        float s = 0.f;
#pragma unroll
        for (int i = 0; i < 16; ++i) s += ur[lane + 64 * i] * x[i];
        s = wave_sum(s);
        const float a = gelu_tanh(s) * g;
#pragma unroll
        for (int i = 0; i < 16; ++i) o[i] += a * vr[lane + 64 * i];
    }
#pragma unroll
    for (int i = 0; i < 16; ++i) h[(size_t)t * D + lane + 64 * i] += o[i];
}
}

extern "C" void kernel_launch(void* const* d_in, const int* in_sizes, int n_in, void* d_out, int out_size, void* d_ws, size_t ws_size, hipStream_t stream) {
    using namespace nv;
    const float* x = (const float*)d_in[0];
    const float* rel_bias = (const float*)d_in[1];
    const float* norm_mix = (const float*)d_in[2];
    const float* norm_ffn = (const float*)d_in[3];
    const float* attn_w_qkv = (const float*)d_in[4];
    const float* attn_q_gain = (const float*)d_in[5];
    const float* attn_k_gain = (const float*)d_in[6];
    const float* lq1 = (const float*)d_in[7];
    const float* lk1 = (const float*)d_in[8];
    const float* lq2 = (const float*)d_in[9];
    const float* lk2 = (const float*)d_in[10];
    const float* sub_gain = (const float*)d_in[11];
    const float* attn_w_o = (const float*)d_in[12];
    const float* conv_w_in = (const float*)d_in[13];
    const float* conv_w = (const float*)d_in[14];
    const float* conv_w_out = (const float*)d_in[15];
    const float* sgu_w_in = (const float*)d_in[16];
    const float* sgu_v_gain = (const float*)d_in[17];
    const float* sgu_w_s = (const float*)d_in[18];
    const float* sgu_b_s = (const float*)d_in[19];
    const float* sgu_w_out = (const float*)d_in[20];
    const float* peer_w_q = (const float*)d_in[21];
    const float* peer_keys = (const float*)d_in[22];
    const float* peer_u = (const float*)d_in[23];
    const float* peer_v = (const float*)d_in[24];
    float* h = (float*)d_out;
    unsigned char* ws = (unsigned char*)d_ws;
    constexpr size_t MiB = 1u << 20;
    float* hn = (float*)(ws + 0 * MiB);
    float* big = (float*)(ws + 64 * MiB);
    bf16_t* qb = (bf16_t*)(ws + 256 * MiB);
    bf16_t* kb = (bf16_t*)(ws + 288 * MiB);
    bf16_t* vb = (bf16_t*)(ws + 320 * MiB);
    bf16_t* ab = (bf16_t*)(ws + 352 * MiB);
    int* idx = (int*)(ws + 384 * MiB);
    float* gate = (float*)(ws + 392 * MiB);

    hipMemcpyAsync(h, x, (size_t)T * D * 4, hipMemcpyDeviceToDevice, stream);
    for (int i = 0; i < DEPTH; ++i) {
        const int m = i % 3, j = i / 3;
        k_rmsnorm<<<T / 4, 256, 0, stream>>>(h, norm_mix + (size_t)i * D, hn);
        if (m == 0) {
            const float lam_init = 0.8f - 0.6f * expf(-0.3f * (float)i);
            k_sgemm<float, false><<<dim3(3072 / 128, T / 128), 256, 0, stream>>>(hn, D, attn_w_qkv + (size_t)j * D * 3072, 3072, big, 3072, D);
            k_qkv_post<<<T / 4, 256, 0, stream>>>(big, attn_q_gain + j * 64, attn_k_gain + j * 64, qb, kb, vb);
            k_attn_naive<<<BATCH * H * SEQ / 4, 256, 0, stream>>>(qb, kb, vb, rel_bias, lq1 + j * 64, lk1 + j * 64, lq2 + j * 64, lk2 + j * 64, sub_gain + j * 128, lam_init, ab);
            k_sgemm<bf16_t, true><<<dim3(1024 / 128, T / 128), 256, 0, stream>>>(ab, D, attn_w_o + (size_t)j * D * D, D, h, D, D);
        } else if (m == 1) {
            k_sgemm<float, false><<<dim3(3072 / 128, T / 128), 256, 0, stream>>>(hn, D, conv_w_in + (size_t)j * D * 3072, 3072, big, 3072, D);
            k_conv_post<<<T * D / 256, 256, 0, stream>>>(big, conv_w + (size_t)j * 3 * D, ab);
            k_sgemm<bf16_t, true><<<dim3(1024 / 128, T / 128), 256, 0, stream>>>(ab, D, conv_w_out + (size_t)j * D * D, D, h, D, D);
        } else {
            k_sgemm<float, false><<<dim3(2048 / 128, T / 128), 256, 0, stream>>>(hn, D, sgu_w_in + (size_t)j * D * 2048, 2048, big, 2048, D);
            k_sgu_post1<<<T / 4, 256, 0, stream>>>(big, sgu_v_gain + (size_t)j * D);
            k_sgu_spatial<<<T * D / 256, 256, 0, stream>>>(big, sgu_w_s + (size_t)j * 8 * 128 * 128, sgu_b_s + (size_t)j * 8 * 128, ab);
            k_sgemm<bf16_t, true><<<dim3(1024 / 128, T / 128), 256, 0, stream>>>(ab, D, sgu_w_out + (size_t)j * D * D, D, h, D, D);
        }
        k_rmsnorm<<<T / 4, 256, 0, stream>>>(h, norm_ffn + (size_t)i * D, hn);
        k_sgemm<float, false><<<dim3(2048 / 128, T / 128), 256, 0, stream>>>(hn, D, peer_w_q + (size_t)i * D * 2048, 2048, big, 2048, D);
        k_peer_route<<<T * PH / 64, 64, 0, stream>>>(big, peer_keys + (size_t)i * 8 * 2 * 128 * 128, idx, gate);
        k_peer_expert<<<T / 4, 256, 0, stream>>>(hn, idx, gate, peer_u + (size_t)i * NEXP * D, peer_v + (size_t)i * NEXP * D, h);
    }
}
```

```cpp
#include <hip/hip_runtime.h>
#include <hip/hip_bf16.h>
#include <cstdio>
#include <cstdint>
#include <cmath>
constexpr int NWAVES = 8;
constexpr int T = 16384, D = 1024, SEQ = 2048, BATCH = 8, DEPTH = 4, NEXP = 16384;
constexpr float EPS = 1e-6f, LOG2E = 1.4426950408889634f;
constexpr size_t MiB = 1u << 20;
constexpr size_t WS_CTL = 0, CTL_ZERO_BYTES = 1 * MiB;
constexpr size_t WS_WQKV = 2 * MiB;
constexpr size_t WS_WO = 14 * MiB;
constexpr size_t WS_CIN = 18 * MiB;
constexpr size_t WS_COUT = 24 * MiB;
constexpr size_t WS_SIN = 26 * MiB;
constexpr size_t WS_SOUT = 30 * MiB;
constexpr size_t WS_SWS = 32 * MiB;
constexpr size_t WS_PWQ = 34 * MiB;
constexpr size_t WS_PKEY = 50 * MiB;
constexpr size_t WS_BTAB = 52 * MiB;
constexpr size_t WS_PART = 54 * MiB;
constexpr size_t WS_PART2 = 55 * MiB;
constexpr size_t WS_SU = 56 * MiB;
constexpr size_t WS_SV = 57 * MiB;
constexpr size_t WS_U8 = 64 * MiB;
constexpr size_t WS_STASH = 96 * MiB;
constexpr size_t WS_V8 = 128 * MiB;
constexpr size_t WS_HBF = 200 * MiB;
constexpr size_t WS_QB = 232 * MiB, WS_KB = 264 * MiB, WS_VB = 296 * MiB;
constexpr size_t WS_O2 = 328 * MiB;
constexpr size_t WS_AB = 392 * MiB;
constexpr size_t WS_IDX = 424 * MiB, WS_GATE = 432 * MiB;
constexpr size_t WS_END = 440 * MiB;
constexpr int CW_TMO = 0, CW_BAR = 4096;
constexpr int RING_OFF = 0, RING_BYTES = 131072;
constexpr int LDS_BYTES = 163840;
constexpr int MISC_OFF = LDS_BYTES - 512;
#ifndef U_FP4
#define U_FP4 1
#endif
#ifndef V_FP4
#define V_FP4 1
#endif
constexpr bool UF4 = U_FP4 != 0, VF4 = V_FP4 != 0;
constexpr int URB = UF4 ? 512 : 1024, VRB = VF4 ? 512 : 1024;
typedef unsigned v2u __attribute__((ext_vector_type(2)));
namespace pg8 {
#define PG8_LAS __attribute__((address_space(3)))
typedef unsigned short bf16_t;
typedef short bf16x8 __attribute__((ext_vector_type(8)));
typedef float f32x4 __attribute__((ext_vector_type(4)));
typedef unsigned u32x4 __attribute__((ext_vector_type(4)));
constexpr int BM = 256, BK = 64, HALF = 128, HTB = HALF * BK * 2  , STAGE_BYTES = 8 * HTB, NXCD = 8, WGM = 8;

__host__ __device__ __forceinline__ int lds_byte(int r, int c) { const int st = (r >> 4) * 2 + (c >> 5), rr = r & 15, cc = c & 31, ob = rr * 64 + cc * 2; return st * 1024 + (ob ^ (((ob >> 9) & 1) << 5)); }
__host__ __device__ __forceinline__ void stage_rc(int b, int& R, int& C) { const int st = b / 1024, sb = b % 1024, swz = sb ^ (((sb >> 9) & 1) << 5); R = (st >> 1) * 16 + swz / 64; C = (st & 1) * 32 + (swz % 64) / 2; }
__host__ __device__ __forceinline__ int perm32(int rho) { const int n = rho >> 4, i = rho & 15; return 8 * (i >> 2) + 4 * n + (i & 3); }

struct Unit { int pm, pn; };
struct Gemm { const bf16_t* A; const bf16_t* Bt; };

template <int NN> struct StaticOrderT {
    static constexpr int nM = 16384 / BM, nN = NN / BM, nwg = nM * nN;
    int G, c;
    __host__ __device__ void init(int G_, int c_) { G = G_; c = c_; }
    __host__ __device__ bool next(int i, Unit& u) const {
        const long L = (long)i * G + c; if (L >= nwg) return false;
        int wgid = (int)L; { constexpr int q = nwg / NXCD, r = nwg % NXCD; const int xcd = wgid % NXCD, off = wgid / NXCD; wgid = (xcd < r ? xcd * (q + 1) : r * (q + 1) + (xcd - r) * q) + off; }
        constexpr int nig = WGM * nN; const int gid = wgid / nig, fm = gid * WGM, gsz = (nM - fm) < WGM ? (nM - fm) : WGM;
        u.pm = fm + ((wgid % nig) % gsz); u.pn = (wgid % nig) / gsz; return true;
    }
    __device__ __forceinline__ void a_ready(const Unit&) const {}
    __device__ __forceinline__ void done(const Unit&) const {}
};

__device__ __forceinline__ unsigned cvt_pk_bf16(float lo, float hi) { unsigned r; asm volatile("v_cvt_pk_bf16_f32 %0, %1, %2" : "=v"(r) : "v"(lo), "v"(hi)); return r; }
typedef float f32x2 __attribute__((ext_vector_type(2)));
constexpr float K_EPS = 1e-6f;
__device__ __forceinline__ void st16_wt(void* p, u32x4 v) { asm volatile("global_store_dwordx4 %0, %1, off sc0 sc1\n\ts_nop 1" :: "v"(p), "v"(v) : "memory"); }
__device__ __forceinline__ void st8_wt(void* p, unsigned lo, unsigned hi) { typedef unsigned u32x2w __attribute__((ext_vector_type(2))); const u32x2w v = {lo, hi}; asm volatile("global_store_dwordx2 %0, %1, off sc0 sc1\n\ts_nop 1" :: "v"(p), "v"(v) : "memory"); }
constexpr float K_LOG2E = 1.4426950408889634f;
__device__ __forceinline__ unsigned pk_bf16(float lo, float hi) { f32x2 v = {lo, hi}; typedef __bf16 bf16x2_t __attribute__((ext_vector_type(2))); bf16x2_t b = __builtin_convertvector(v, bf16x2_t); return __builtin_bit_cast(unsigned, b); }
__device__ __forceinline__ float gelu_t(float x) {
    const float y = 0.7978845608028654f * (x + 0.044715f * x * x * x);
    return x * __builtin_amdgcn_rcpf(1.0f + __builtin_amdgcn_exp2f(-2.0f * K_LOG2E * y));
}
__device__ __forceinline__ float row_rstd(const float* part, int row, int fq) {
    const f32x4 v = *(const f32x4*)(part + (size_t)row * 16 + 4 * fq);
    float s = (v[0] + v[1]) + (v[2] + v[3]);
    s += __shfl_xor(s, 16); s += __shfl_xor(s, 32);
    return __builtin_amdgcn_rsqf(s * (1.0f / 1024.0f) + K_EPS);
}
struct EpiResid {
    static constexpr bool PERM = false, AFTER_DRAIN = false;
    unsigned char* ws; float sc;
    __device__ __forceinline__ void operator()(const f32x4 (&acc)[2][2][4][2], const Unit& u, int wr, int wc, int fr, int fq) const {
        const int col0 = u.pn * BM + wc * 32 + 4 * fq; bf16_t* hbf = (bf16_t*)(ws + WS_HBF); float* part = (float*)(ws + WS_PART);
        typedef unsigned u32x2 __attribute__((ext_vector_type(2)));
#pragma unroll
        for (int ai = 0; ai < 2; ++ai)
#pragma unroll
            for (int m = 0; m < 4; ++m) {
                const int row = u.pm * BM + ai * HALF + wr * 64 + m * 16 + fr; const size_t off = (size_t)row * 1024 + col0; float ss = 0.f;
#pragma unroll
                for (int bj = 0; bj < 2; ++bj)
#pragma unroll
                    for (int n = 0; n < 2; ++n) {
                        u32x2* q = (u32x2*)(hbf + off + bj * HALF + n * 16); const u32x2 o = *q; const f32x4 a = acc[ai][bj][m][n] * sc;
                        const f32x4 v = {__uint_as_float(o.x << 16) + a[0], __uint_as_float(o.x & 0xffff0000u) + a[1], __uint_as_float(o.y << 16) + a[2], __uint_as_float(o.y & 0xffff0000u) + a[3]};
                        ss += (v[0] * v[0] + v[1] * v[1]) + (v[2] * v[2] + v[3] * v[3]);
                        u32x2 w; w.x = pk_bf16(v[0], v[1]); w.y = pk_bf16(v[2], v[3]); *q = w; }
                ss += __shfl_xor(ss, 16); ss += __shfl_xor(ss, 32);
                if (fq == 0) part[(size_t)row * 16 + u.pn * 4 + wc] = ss;
                if (m & 1) asm volatile("" ::: "memory");
            }
    }
};
struct EpiQKV {
    static constexpr bool PERM = true, AFTER_DRAIN = false;
    unsigned char* ws; const float* qg; const float* kg;
    __device__ __forceinline__ void operator()(const f32x4 (&acc)[2][2][4][2], const Unit& u, int wr, int wc, int fr, int fq) const {
        const int sec = u.pn >> 2; bf16_t* dst = (bf16_t*)(ws + WS_QB + (size_t)sec * (WS_KB - WS_QB)); const float* part = (const float*)(ws + WS_PART); constexpr float c2 = 0.125f * K_LOG2E;
        const int colb = (u.pn & 3) * BM + 64 * wc + 8 * fq;
        f32x4 g[2][2];
#pragma unroll
        for (int bj = 0; bj < 2; ++bj)
#pragma unroll
            for (int n = 0; n < 2; ++n) { g[bj][n] = (f32x4){1.f, 1.f, 1.f, 1.f};
                if (sec < 2) { const f32x4 t = *(const f32x4*)((sec == 0 ? qg : kg) + 32 * bj + 8 * fq + 4 * n); g[bj][n] = sec == 0 ? t * c2 : t; } }
#pragma unroll
        for (int ai = 0; ai < 2; ++ai)
#pragma unroll
            for (int m = 0; m < 4; ++m) {
                const int row = u.pm * BM + ai * HALF + wr * 64 + m * 16 + fr; const float rs = row_rstd(part, row, fq);
                f32x4 v[2][2]; float ss = 0.f;
#pragma unroll
                for (int bj = 0; bj < 2; ++bj)
#pragma unroll
                    for (int n = 0; n < 2; ++n) { v[bj][n] = acc[ai][bj][m][n] * rs; ss += (v[bj][n][0] * v[bj][n][0] + v[bj][n][1] * v[bj][n][1]) + (v[bj][n][2] * v[bj][n][2] + v[bj][n][3] * v[bj][n][3]); }
                float rn = 1.f;
                if (sec < 2) { ss += __shfl_xor(ss, 16); ss += __shfl_xor(ss, 32); rn = __builtin_amdgcn_rsqf(ss * (1.0f / 64.0f) + K_EPS); }
#pragma unroll
                for (int bj = 0; bj < 2; ++bj) { const f32x4 a = v[bj][0] * rn * g[bj][0], b = v[bj][1] * rn * g[bj][1];
                    u32x4 w; w.x = pk_bf16(a[0], a[1]); w.y = pk_bf16(a[2], a[3]); w.z = pk_bf16(b[0], b[1]); w.w = pk_bf16(b[2], b[3]);
                    st16_wt(dst + (size_t)row * 1024 + colb + 32 * bj, w); }
            }
    }
};
struct EpiConvIn {
    static constexpr bool PERM = true, AFTER_DRAIN = false;
    unsigned char* ws;
    __device__ __forceinline__ void operator()(const f32x4 (&acc)[2][2][4][2], const Unit& u, int wr, int wc, int fr, int fq) const {
        const float* part = (const float*)(ws + WS_PART); bf16_t* bc = (bf16_t*)(ws + WS_QB); bf16_t* z = (bf16_t*)(ws + WS_KB);
#pragma unroll
        for (int ai = 0; ai < 2; ++ai)
#pragma unroll
            for (int m = 0; m < 4; ++m) {
                const int row = u.pm * BM + ai * HALF + wr * 64 + m * 16 + fr; const float rs = row_rstd(part, row, fq);
                if (u.pn < 4) {
#pragma unroll
                    for (int bj = 0; bj < 2; ++bj) { const f32x4 a = acc[ai][bj][m][0] * rs, b = acc[ai][bj][m][1] * rs;
                        u32x4 w; w.x = pk_bf16(a[0], a[1]); w.y = pk_bf16(a[2], a[3]); w.z = pk_bf16(b[0], b[1]); w.w = pk_bf16(b[2], b[3]);
                        st16_wt(bc + (size_t)row * 1024 + u.pn * BM + bj * HALF + wc * 32 + 8 * fq, w); }
                } else { const float r2 = rs * rs;
                    const f32x4 a = acc[ai][0][m][0] * acc[ai][1][m][0] * r2, b = acc[ai][0][m][1] * acc[ai][1][m][1] * r2;
                    u32x4 w; w.x = pk_bf16(a[0], a[1]); w.y = pk_bf16(a[2], a[3]); w.z = pk_bf16(b[0], b[1]); w.w = pk_bf16(b[2], b[3]);
                    st16_wt(z + (size_t)row * 1024 + (u.pn - 4) * HALF + wc * 32 + 8 * fq, w); }
            }
    }
};
struct EpiSguIn {
    static constexpr bool PERM = true, AFTER_DRAIN = false;
    unsigned char* ws;
    __device__ __forceinline__ void operator()(const f32x4 (&acc)[2][2][4][2], const Unit& u, int wr, int wc, int fr, int fq) const {
        const float* part = (const float*)(ws + WS_PART); bf16_t* zg = (bf16_t*)(ws + WS_QB); float* part2 = (float*)(ws + WS_PART2);
#pragma unroll
        for (int ai = 0; ai < 2; ++ai)
#pragma unroll
            for (int m = 0; m < 4; ++m) {
                const int row = u.pm * BM + ai * HALF + wr * 64 + m * 16 + fr; const float rs = row_rstd(part, row, fq); float ss = 0.f;
#pragma unroll
                for (int bj = 0; bj < 2; ++bj) { f32x4 a = acc[ai][bj][m][0] * rs, b = acc[ai][bj][m][1] * rs;
#pragma unroll
                    for (int j = 0; j < 4; ++j) { a[j] = gelu_t(a[j]); b[j] = gelu_t(b[j]); ss += a[j] * a[j] + b[j] * b[j]; }
                    u32x4 w; w.x = pk_bf16(a[0], a[1]); w.y = pk_bf16(a[2], a[3]); w.z = pk_bf16(b[0], b[1]); w.w = pk_bf16(b[2], b[3]);
                    st16_wt(zg + (size_t)row * 2048 + u.pn * BM + bj * HALF + wc * 32 + 8 * fq, w); }
                if (u.pn >= 4) { ss += __shfl_xor(ss, 16); ss += __shfl_xor(ss, 32); if (fq == 0) part2[(size_t)row * 16 + (u.pn - 4) * 4 + wc] = ss; }
            }
    }
};
__device__ __forceinline__ void ce_desc(float& a, float& b) { const float hi = __builtin_fmaxf(a, b), lo = __builtin_fminf(a, b); a = hi; b = lo; }
template <int N> __device__ __forceinline__ void bitonic_sort_desc(float (&v)[N]) {
#pragma unroll
    for (int k = 2; k <= N; k <<= 1)
#pragma unroll
        for (int j = k >> 1; j > 0; j >>= 1)
#pragma unroll
            for (int i = 0; i < N; ++i) { const int l = i ^ j; if (l > i) { if ((i & k) == 0) ce_desc(v[i], v[l]); else ce_desc(v[l], v[i]); } }
}
__device__ __forceinline__ void bitonic_merge_desc16(float (&v)[16]) {
#pragma unroll
    for (int j = 8; j > 0; j >>= 1)
#pragma unroll
        for (int i = 0; i < 16; ++i) { const int l = i ^ j; if (l > i) ce_desc(v[i], v[l]); }
}
__device__ __forceinline__ void merge_top16(float (&a)[16], const float (&b)[16]) {
#pragma unroll
    for (int i = 0; i < 16; ++i) a[i] = __builtin_fmaxf(a[i], b[15 - i]);
    bitonic_merge_desc16(a);
}
__device__ __forceinline__ void ce2_desc(float& av, int& ai, float& bv, int& bi) {
    float hv; int hi;
    asm("v_cmp_lt_f32 vcc, %4, %1\n\tv_cndmask_b32 %0, %4, %1, vcc\n\tv_cndmask_b32 %2, %5, %3, vcc\n\tv_cndmask_b32 %1, %1, %4, vcc\n\tv_cndmask_b32 %3, %3, %5, vcc"
        : "=&v"(hv), "+v"(bv), "=&v"(hi), "+v"(bi) : "v"(av), "v"(ai) : "vcc");
    av = hv; ai = hi;
}
__device__ __forceinline__ void bitonic_merge2_desc16(float (&v)[16], int (&p)[16]) {
#pragma unroll
    for (int j = 8; j > 0; j >>= 1)
#pragma unroll
        for (int i = 0; i < 16; ++i) { const int l = i ^ j; if (l > i) ce2_desc(v[i], p[i], v[l], p[l]); }
}
__device__ __forceinline__ void bitonic_sort2_desc16(float (&v)[16], int (&p)[16]) {
#pragma unroll
    for (int k = 2; k <= 16; k <<= 1)
#pragma unroll
        for (int j = k >> 1; j > 0; j >>= 1)
#pragma unroll
            for (int i = 0; i < 16; ++i) { const int l = i ^ j; if (l > i) { if ((i & k) == 0) ce2_desc(v[i], p[i], v[l], p[l]); else ce2_desc(v[l], p[l], v[i], p[i]); } }
}
__device__ __forceinline__ void merge2_top16(float (&av)[16], int (&ap)[16], const float (&bv)[16], const int (&bp)[16]) {
#pragma unroll
    for (int i = 0; i < 16; ++i) { asm("v_cmp_lt_f32 vcc, %0, %2\n\tv_cndmask_b32 %0, %0, %2, vcc\n\tv_cndmask_b32 %1, %1, %3, vcc" : "+v"(av[i]), "+v"(ap[i]) : "v"(bv[15 - i]), "v"(bp[15 - i]) : "vcc"); }
    bitonic_merge2_desc16(av, ap);
}
__device__ __forceinline__ double mk64(float v, int p) { return __builtin_bit_cast(double, ((unsigned long long)__float_as_uint(v) << 32) | (unsigned long long)(unsigned)p); }
__device__ __forceinline__ double max64(double a, double b) { double r; asm("v_max_f64 %0, %1, %2" : "=v"(r) : "v"(a), "v"(b)); return r; }
__device__ __forceinline__ double min64(double a, double b) { double r; asm("v_min_f64 %0, %1, %2" : "=v"(r) : "v"(a), "v"(b)); return r; }
__device__ __forceinline__ void ce_desc_d(double& a, double& b) { const double hi = max64(a, b), lo = min64(a, b); a = hi; b = lo; }
__device__ __forceinline__ void bitonic_merge_desc16_d(double (&v)[16]) {
#pragma unroll
    for (int j = 8; j > 0; j >>= 1)
#pragma unroll
        for (int i = 0; i < 16; ++i) { const int l = i ^ j; if (l > i) ce_desc_d(v[i], v[l]); }
}
__device__ __forceinline__ void bitonic_sort_desc16_d(double (&v)[16]) {
#pragma unroll
    for (int k = 2; k <= 16; k <<= 1)
#pragma unroll
        for (int j = k >> 1; j > 0; j >>= 1)
#pragma unroll
            for (int i = 0; i < 16; ++i) { const int l = i ^ j; if (l > i) { if ((i & k) == 0) ce_desc_d(v[i], v[l]); else ce_desc_d(v[l], v[i]); } }
}
__device__ __forceinline__ void merge_top16_d(double (&a)[16], const double (&b)[16]) {
#pragma unroll
    for (int i = 0; i < 16; ++i) a[i] = max64(a[i], b[15 - i]);
    bitonic_merge_desc16_d(a);
}
constexpr int RT_STRIDE = 544;
struct EpiRoute {
    static constexpr bool PERM = true, AFTER_DRAIN = true;
    unsigned char* ws; int layer;
    int mode; Unit prev;
    __device__ __forceinline__ void half_top16(const f32x4 (&s)[8], int fq, float (&top)[16]) const {
        float lo[16], hi[16];
#pragma unroll
        for (int n = 0; n < 4; ++n)
#pragma unroll
            for (int j = 0; j < 4; ++j) {
                lo[n * 4 + j] = __uint_as_float((__float_as_uint(s[n][j]) & ~127u) | (unsigned)(16 * n + 4 * fq + j));
                hi[n * 4 + j] = __uint_as_float((__float_as_uint(s[n + 4][j]) & ~127u) | (unsigned)(16 * (n + 4) + 4 * fq + j)); }
        bitonic_sort_desc<16>(lo); bitonic_sort_desc<16>(hi); merge_top16(lo, hi);
#pragma unroll
        for (int st = 16; st <= 32; st <<= 1) { float o[16];
#pragma unroll
            for (int i = 0; i < 16; ++i) o[i] = __shfl_xor(lo[i], st);
            merge_top16(lo, o); }
#pragma unroll
        for (int i = 0; i < 16; ++i) top[i] = lo[i];
    }
    __device__ __forceinline__ void fused(f32x4 (&acc)[2][2][4][2], const Unit& u, int wr, int wc, int fr, int fq, PG8_LAS unsigned char* lds, int wid, int lane) const {
        const int hp = u.pn; const float* part = (const float*)(ws + WS_PART); const bf16_t* keys = (const bf16_t*)(ws + WS_PKEY) + (size_t)layer * 8 * 2 * 128 * 128; int* idx = (int*)(ws + WS_IDX); float* gate = (float*)(ws + WS_GATE);
        constexpr int KOFF = 128 * RT_STRIDE, KSTRIDE = 288;
        { const int tid = wid * 64 + lane; const bf16_t* kh = keys + (size_t)hp * 2 * 128 * 128;
#pragma unroll
          for (int i = 0; i < 8; ++i) { const int q = tid + 512 * i, kr = q >> 4, c = q & 15; *(PG8_LAS u32x4*)(lds + KOFF + kr * KSTRIDE + c * 16) = *(const u32x4*)(kh + (size_t)kr * 128 + c * 8); } }
        float ta0[16], tb0[16], ta1[16], tb1[16];
        f32x4* stash = (f32x4*)(ws + WS_STASH) + ((size_t)blockIdx.x * 8 + wid) * 256;
        f32x4 sa[4], sb[4];
#pragma unroll
        for (int i = 0; i < 4; ++i) { sa[i] = (f32x4){0.f, 0.f, 0.f, 0.f}; sb[i] = sa[i]; }
#pragma unroll
        for (int ai = 0; ai < 2; ++ai) {
#pragma unroll
            for (int m = 0; m < 4; ++m) { const int rl = wr * 64 + m * 16 + fr; const float rs = row_rstd(part, u.pm * BM + ai * HALF + rl, fq);
#pragma unroll
                for (int bj = 0; bj < 2; ++bj) { const f32x4 a = acc[ai][bj][m][0] * rs, b = acc[ai][bj][m][1] * rs;
                    u32x4 w; w.x = pk_bf16(a[0], a[1]); w.y = pk_bf16(a[2], a[3]); w.z = pk_bf16(b[0], b[1]); w.w = pk_bf16(b[2], b[3]);
                    *(PG8_LAS u32x4*)(lds + rl * RT_STRIDE + (64 * wc + 32 * bj + 8 * fq) * 2) = w; } }
            asm volatile("s_waitcnt vmcnt(0) lgkmcnt(0)" ::: "memory"); __builtin_amdgcn_s_barrier(); asm volatile("" ::: "memory");
            if (ai == 1 && mode == 2) {
#pragma unroll
                for (int i = 0; i < 4; ++i) { sa[i] = stash[((fq & 1) * 2 + 0) * 64 + fr * 4 + i]; sb[i] = stash[((fq & 1) * 2 + 1) * 64 + fr * 4 + i]; } }
            const int rl = 16 * wid + fr;
#pragma unroll
            for (int p = 0; p < 2; ++p) {
                f32x4 s[8];
#pragma unroll
                for (int n = 0; n < 8; ++n) s[n] = (f32x4){0.f, 0.f, 0.f, 0.f};
#pragma unroll
                for (int kk = 0; kk < 4; ++kk) {
                    const bf16x8 qf = *(const PG8_LAS bf16x8*)(lds + rl * RT_STRIDE + (p * 128 + 32 * kk + 8 * fq) * 2);
#pragma unroll
                    for (int n = 0; n < 8; ++n) { const bf16x8 kf = *(const PG8_LAS bf16x8*)(lds + KOFF + (p * 128 + 16 * n + fr) * KSTRIDE + (32 * kk + 8 * fq) * 2);
                        s[n] = __builtin_amdgcn_mfma_f32_16x16x32_bf16(kf, qf, s[n], 0, 0, 0); } }
                if (ai == 0) { if (p == 0) half_top16(s, fq, ta0); else half_top16(s, fq, tb0); } else { if (p == 0) half_top16(s, fq, ta1); else half_top16(s, fq, tb1); }
            }
            asm volatile("s_waitcnt lgkmcnt(0)" ::: "memory"); __builtin_amdgcn_s_barrier(); asm volatile("" ::: "memory");
        }
        if (mode == 1) {
            if (fq == 0) {
#pragma unroll
                for (int i = 0; i < 4; ++i) {
                    stash[0 * 64 + fr * 4 + i] = (f32x4){ta0[4 * i], ta0[4 * i + 1], ta0[4 * i + 2], ta0[4 * i + 3]}; stash[1 * 64 + fr * 4 + i] = (f32x4){tb0[4 * i], tb0[4 * i + 1], tb0[4 * i + 2], tb0[4 * i + 3]};
                    stash[2 * 64 + fr * 4 + i] = (f32x4){ta1[4 * i], ta1[4 * i + 1], ta1[4 * i + 2], ta1[4 * i + 3]}; stash[3 * 64 + fr * 4 + i] = (f32x4){tb1[4 * i], tb1[4 * i + 1], tb1[4 * i + 2], tb1[4 * i + 3]}; } }
            return;
        }
        {
            const int aisel = fq & 1; const bool useprev = mode == 2 && fq < 2; const bool active = mode == 2 || fq < 2;
            const int upm = useprev ? prev.pm : u.pm, hpx = useprev ? prev.pn : hp;
            const int row = upm * BM + aisel * HALF + 16 * wid + fr;
            float ta[16], tb[16];
#pragma unroll
            for (int i = 0; i < 16; ++i) { float a0 = ta0[i], a1 = ta1[i], b0 = tb0[i], b1 = tb1[i], pa = sa[i >> 2][i & 3], pb = sb[i >> 2][i & 3]; asm volatile("" : "+v"(a0), "+v"(a1), "+v"(b0), "+v"(b1), "+v"(pa), "+v"(pb));
                const float xa = aisel ? a1 : a0, xb = aisel ? b1 : b0; ta[i] = useprev ? pa : xa; tb[i] = useprev ? pb : xb; }
            int ka[16], kb[16];
#pragma unroll
            for (int i = 0; i < 16; ++i) { ka[i] = (int)(__float_as_uint(ta[i]) & 127u) << 7; kb[i] = (int)(__float_as_uint(tb[i]) & 127u); }
            double d1[16], d2[16];
#pragma unroll
            for (int j = 0; j < 16; ++j) d1[j] = mk64(ta[0] + tb[j], ka[0] | kb[j]);
#pragma unroll
            for (int j = 0; j < 8; ++j) { d2[j] = mk64(ta[1] + tb[j], ka[1] | kb[j]); d2[8 + j] = mk64(ta[15 - j] + tb[0], ka[15 - j] | kb[0]); }
            bitonic_merge_desc16_d(d2);
            merge_top16_d(d1, d2);
            {
                constexpr int RI[16] = {2, 2, 2, 2, 2, 3, 3, 3, 3, 4, 4, 4, 5, 5, 6, 6}, RJ[16] = {0, 1, 2, 3, 4, 0, 1, 2, 3, 0, 1, 2, 0, 1, 0, 1};
#pragma unroll
                for (int q = 0; q < 16; ++q) d2[q] = mk64(ta[RI[q]] + tb[RJ[q]], ka[RI[q]] | kb[RJ[q]]);
                bitonic_sort_desc16_d(d2);
                merge_top16_d(d1, d2);
            }
#pragma unroll
            for (int jj = 0; jj < 2; ++jj) { double c = mk64(ta[7] + tb[jj], ka[7] | kb[jj]);
#pragma unroll
                for (int i = 0; i < 16; ++i) ce_desc_d(d1[i], c); }
            float v1[16]; int p1[16];
#pragma unroll
            for (int i = 0; i < 16; ++i) { const unsigned long long w = __builtin_bit_cast(unsigned long long, d1[i]); v1[i] = __uint_as_float((unsigned)(w >> 32)); p1[i] = (int)(unsigned)w; }
            float ex[16]; float sum = 0.f;
#pragma unroll
            for (int i = 0; i < 16; ++i) { ex[i] = __builtin_amdgcn_exp2f((v1[i] - v1[0]) * K_LOG2E); sum += ex[i]; }
            const float inv = __builtin_amdgcn_rcpf(sum);
            if (active) {
                int* ip = idx + (size_t)row * 128 + hpx * 16; float* gp = gate + (size_t)row * 128 + hpx * 16;
#pragma unroll
                for (int i = 0; i < 16; i += 4) { typedef int i32x4 __attribute__((ext_vector_type(4)));
                    *(i32x4*)(ip + i) = (i32x4){p1[i], p1[i + 1], p1[i + 2], p1[i + 3]};
                    *(f32x4*)(gp + i) = (f32x4){ex[i] * inv, ex[i + 1] * inv, ex[i + 2] * inv, ex[i + 3] * inv}; }
            }
        }
    }
};
struct OneUnit {
    StaticOrderT<2048> S; int k;
    __device__ __forceinline__ bool next(int i, Unit& u) const { return i == 0 ? S.next(k, u) : false; }
    __device__ __forceinline__ void a_ready(const Unit&) const {}
    __device__ __forceinline__ void done(const Unit&) const {}
};
template <class Epi, class Sched, bool ALIGN_EPI = false, bool SP2 = false>
__device__ __forceinline__ void gemm_phase(PG8_LAS unsigned char* lds, const Gemm g, const Sched& S, const Epi& E) {
    int tid_ = threadIdx.x; asm volatile("" : "+v"(tid_));
    const int tid = tid_, wid = __builtin_amdgcn_readfirstlane(tid >> 6), lane = tid & 63, wr = wid >> 2, wc = wid & 3, fr = lane & 15, fq = lane >> 4;
    constexpr int K = 1024, nt = K / BK;
    unsigned voffA[2], voffB[2];
#pragma unroll
    for (int i = 0; i < 2; ++i) { int R, C; stage_rc(tid * 16 + i * 8192, R, C); const int Rb = Epi::PERM ? ((R & ~31) + perm32(R & 31)) : R;
        voffA[i] = (unsigned)(R * K + C) * 2u; voffB[i] = (unsigned)(Rb * K + C) * 2u; }
    const size_t kstep = (size_t)(BK * 2);
    const size_t hstep = (size_t)HALF * K * 2;
    const size_t tstep = 2 * hstep;
    const unsigned ldsw = (unsigned)wid * 1024u;
    const int aoff = lds_byte(wr * 64 + fr, fq * 8), boff = lds_byte(wc * 32 + fr, fq * 8);
#define PG8_SA(b, h) (((b) * 2 + (h)) * HTB)
#define PG8_SB(b, h) ((4 + (b) * 2 + (h)) * HTB)
#define PG8_STAGE(bufoff, gbase, voff) do { _Pragma("unroll") for (int _i = 0; _i < 2; ++_i) \
        __builtin_amdgcn_global_load_lds((const unsigned*)((const char*)(gbase) + (voff)[_i]), (PG8_LAS unsigned*)(lds + (bufoff) + ldsw + _i * 8192), 16, 0, 0); } while (0)
#define PG8_LDA(dst, b, h) do { _Pragma("unroll") for (int m = 0; m < 4; ++m) _Pragma("unroll") for (int k = 0; k < 2; ++k) dst[m][k] = *(const PG8_LAS bf16x8*)(lds + PG8_SA(b, h) + aoff + m * 2048 + k * 1024); } while (0)
#define PG8_LDB(dst, b, h) do { _Pragma("unroll") for (int n = 0; n < 2; ++n) _Pragma("unroll") for (int k = 0; k < 2; ++k) dst[n][k] = *(const PG8_LAS bf16x8*)(lds + PG8_SB(b, h) + boff + n * 2048 + k * 1024); } while (0)
#define PG8_MMA(ai, bj, At, Bt) do { __builtin_amdgcn_s_setprio(1); _Pragma("unroll") for (int m = 0; m < 4; ++m) _Pragma("unroll") for (int n = 0; n < 2; ++n) _Pragma("unroll") for (int k = 0; k < 2; ++k) \
        acc[ai][bj][m][n] = __builtin_amdgcn_mfma_f32_16x16x32_bf16(Bt[n][k], At[m][k], acc[ai][bj][m][n], 0, 0, 0); __builtin_amdgcn_s_setprio(0); } while (0)
#define PG8_WAIT_V(n) asm volatile("s_waitcnt vmcnt(" #n ")" ::: "memory")
#define PG8_WAIT_L(n) asm volatile("s_waitcnt lgkmcnt(" #n ")" ::: "memory")
#define PG8_BAR __builtin_amdgcn_s_barrier()
#define PG8_SCHED __builtin_amdgcn_sched_barrier(0)
    Unit cur, nxt; int ui = 0;
    if (!S.next(0, cur)) return;
    f32x4 acc[2][2][4][2];
#pragma unroll
    for (int a = 0; a < 2; ++a)
#pragma unroll
        for (int b = 0; b < 2; ++b)
#pragma unroll
            for (int m = 0; m < 4; ++m)
#pragma unroll
                for (int n = 0; n < 2; ++n) acc[a][b][m][n] = (f32x4){0.f, 0.f, 0.f, 0.f};
    bf16x8 At[4][2], B0[2][2], B1[2][2];
    const char* cA = (const char*)g.A + (size_t)cur.pm * tstep; const char* cB = (const char*)g.Bt + (size_t)cur.pn * tstep;
    S.a_ready(cur);
    if constexpr (SP2) {
        PG8_STAGE(PG8_SB(0, 0), cB, voffB); PG8_STAGE(PG8_SB(0, 1), cB + hstep, voffB); PG8_STAGE(PG8_SA(0, 0), cA, voffA); PG8_STAGE(PG8_SA(0, 1), cA + hstep, voffA);
        if (wr == 1) PG8_BAR;
        PG8_WAIT_V(2); PG8_BAR;
        PG8_STAGE(PG8_SB(1, 0), cB + kstep, voffB); PG8_STAGE(PG8_SA(1, 0), cA + kstep, voffA); PG8_STAGE(PG8_SB(1, 1), cB + hstep + kstep, voffB);
        PG8_WAIT_V(6); PG8_BAR;
    } else {
        PG8_STAGE(PG8_SB(0, 0), cB, voffB); PG8_STAGE(PG8_SA(0, 0), cA, voffA); PG8_STAGE(PG8_SB(0, 1), cB + hstep, voffB); PG8_STAGE(PG8_SA(0, 1), cA + hstep, voffA);
        if (wr == 1) PG8_BAR;
        PG8_WAIT_V(4); PG8_BAR;
        PG8_STAGE(PG8_SB(1, 0), cB + kstep, voffB); PG8_STAGE(PG8_SA(1, 0), cA + kstep, voffA); PG8_STAGE(PG8_SB(1, 1), cB + hstep + kstep, voffB);
        PG8_WAIT_V(6); PG8_BAR;
    }
    for (;;) {
        const bool has_next = S.next(ui + 1, nxt);
        const char* nA = has_next ? (const char*)g.A + (size_t)nxt.pm * tstep : cA; const char* nB = has_next ? (const char*)g.Bt + (size_t)nxt.pn * tstep : cB;
        for (int t = 0; t < nt; t += 2) {
            const bool last = (t == nt - 2);
            const char* a1 = cA + (size_t)(t + 1) * kstep;
            const char* a2 = last ? nA : cA + (size_t)(t + 2) * kstep; const char* b2 = last ? nB : cB + (size_t)(t + 2) * kstep;
            const char* a3 = a2 + kstep; const char* b3 = b2 + kstep;
            if (last && has_next) S.a_ready(nxt);
            if constexpr (SP2) {
            PG8_LDB(B0, 0, 0); PG8_LDB(B1, 0, 1); PG8_SCHED; PG8_LDA(At, 0, 0); PG8_STAGE(PG8_SA(1, 1), a1 + hstep, voffA);
            PG8_WAIT_V(8); PG8_WAIT_L(0); PG8_BAR; PG8_MMA(0, 0, At, B0); PG8_MMA(0, 1, At, B1); PG8_BAR; PG8_SCHED;
            PG8_LDA(At, 0, 1); PG8_STAGE(PG8_SB(0, 0), b2, voffB); PG8_STAGE(PG8_SB(0, 1), b2 + hstep, voffB); PG8_STAGE(PG8_SA(0, 0), a2, voffA);
            PG8_WAIT_V(8); PG8_WAIT_L(0); PG8_BAR; PG8_MMA(1, 0, At, B0); PG8_MMA(1, 1, At, B1); PG8_BAR; PG8_SCHED;
            PG8_LDB(B0, 1, 0); PG8_LDB(B1, 1, 1); PG8_SCHED; PG8_LDA(At, 1, 0); PG8_STAGE(PG8_SA(0, 1), a2 + hstep, voffA);
            PG8_WAIT_V(8); PG8_WAIT_L(0); PG8_BAR; PG8_MMA(0, 0, At, B0); PG8_MMA(0, 1, At, B1); PG8_BAR; PG8_SCHED;
            PG8_LDA(At, 1, 1); PG8_STAGE(PG8_SB(1, 0), b3, voffB); PG8_STAGE(PG8_SB(1, 1), b3 + hstep, voffB); PG8_STAGE(PG8_SA(1, 0), a3, voffA);
            PG8_WAIT_V(8); PG8_WAIT_L(0); PG8_BAR; PG8_MMA(1, 0, At, B0); PG8_MMA(1, 1, At, B1); PG8_BAR; PG8_SCHED;
            } else {
            PG8_LDB(B0, 0, 0); PG8_SCHED; PG8_LDA(At, 0, 0); PG8_STAGE(PG8_SA(1, 1), a1 + hstep, voffA);
            PG8_WAIT_L(8); PG8_BAR; PG8_WAIT_L(0); PG8_MMA(0, 0, At, B0); PG8_BAR; PG8_SCHED;
            PG8_LDB(B1, 0, 1); PG8_STAGE(PG8_SB(0, 0), b2, voffB);
            PG8_BAR; PG8_WAIT_L(0); PG8_MMA(0, 1, At, B1); PG8_BAR;
            PG8_LDA(At, 0, 1); PG8_STAGE(PG8_SA(0, 0), a2, voffA);
            PG8_BAR; PG8_WAIT_L(0); PG8_MMA(1, 0, At, B0); PG8_BAR; PG8_SCHED;
            PG8_STAGE(PG8_SB(0, 1), b2 + hstep, voffB);
            PG8_WAIT_V(6); PG8_BAR; PG8_MMA(1, 1, At, B1); PG8_BAR;
            PG8_LDB(B0, 1, 0); PG8_SCHED; PG8_LDA(At, 1, 0); PG8_STAGE(PG8_SA(0, 1), a2 + hstep, voffA);
            PG8_WAIT_L(8); PG8_BAR; PG8_WAIT_L(0); PG8_MMA(0, 0, At, B0); PG8_BAR; PG8_SCHED;
            PG8_LDB(B1, 1, 1); PG8_STAGE(PG8_SB(1, 0), b3, voffB);
            PG8_BAR; PG8_WAIT_L(0); PG8_MMA(0, 1, At, B1); PG8_BAR;
            PG8_LDA(At, 1, 1); PG8_STAGE(PG8_SA(1, 0), a3, voffA);
            PG8_BAR; PG8_WAIT_L(0); PG8_MMA(1, 0, At, B0); PG8_BAR; PG8_SCHED;
            PG8_STAGE(PG8_SB(1, 1), b3 + hstep, voffB);
            PG8_WAIT_V(6); PG8_BAR; PG8_MMA(1, 1, At, B1); PG8_BAR;
            }
        }
        if constexpr (ALIGN_EPI) { if (wr == 0) PG8_BAR; }
        if constexpr (!Epi::AFTER_DRAIN) { E(acc, cur, wr, wc, fr, fq); S.done(cur); }
        if (!has_next) break;
#pragma unroll
        for (int a = 0; a < 2; ++a)
#pragma unroll
            for (int b = 0; b < 2; ++b)
#pragma unroll
                for (int m = 0; m < 4; ++m)
#pragma unroll
                    for (int n = 0; n < 2; ++n) acc[a][b][m][n] = (f32x4){0.f, 0.f, 0.f, 0.f};
        cur = nxt; cA = nA; cB = nB; ++ui;
        if constexpr (ALIGN_EPI) { if (wr == 1) PG8_BAR; }
    }
    PG8_WAIT_V(0);
    if constexpr (!ALIGN_EPI) { if (wr == 0) PG8_BAR; }
    PG8_BAR;
    if constexpr (Epi::AFTER_DRAIN) { E.fused(acc, cur, wr, wc, fr, fq, lds, wid, lane); S.done(cur); }
#undef PG8_SA
#undef PG8_SB
#undef PG8_STAGE
#undef PG8_LDA
#undef PG8_LDB
#undef PG8_MMA
#undef PG8_WAIT_V
#undef PG8_WAIT_L
#undef PG8_BAR
#undef PG8_SCHED
}
}
namespace attn_body {
using bf16=__hip_bfloat16;
using bf16x8=__attribute__((ext_vector_type(8)))short;
using s16x4=__attribute__((ext_vector_type(4)))short;
using f32x16=__attribute__((ext_vector_type(16)))float;
using u32x4=__attribute__((ext_vector_type(4)))unsigned;
constexpr int BATCH=8,NHEAD=16,SEQ=2048,D=64,DM=NHEAD*D,OPITCH=2048;
constexpr int NW=8,QBLK=32,QB=QBLK*NW,KVBLK=64,NQB=SEQ/QB;
constexpr int ATTN_PITCH=DM, ATTN_UNIT_ROWS=QB;
__device__ __forceinline__ int crow(int r,int hi){return (r&3)+8*(r>>2)+4*hi;}
#define SBAR() __builtin_amdgcn_sched_barrier(0)
__device__ __forceinline__ void cmask(f32x16&p0,f32x16&p1,int jb,int qrel,int hi){
  const float NEG=-INFINITY; int kb=64*jb+4*hi;
  #pragma unroll
  for(int r=0;r<16;++r){int kv=kb+(r&3)+8*(r>>2); if(kv>qrel)p0[r]=NEG; if(kv+32>qrel)p1[r]=NEG;}
}

typedef const __attribute__((address_space(3))) float* lds_fptr;
__device__ __forceinline__ void bias_init1(f32x16&c,int sel,int jb,int qrel,int hi,lds_fptr bt,const f32x16&negm){
  const lds_fptr b=bt+(256+qrel-64*jb-4*hi-32*sel);
  #pragma unroll
  for(int r=0;r<16;++r){const int off=(r&3)+8*(r>>2); c[r]=b[-off]+negm[r];}
}
constexpr int NSLOT=3, SLOTB=8192;
constexpr int NVSLOT=4, VSLOTB=16384;
constexpr int LDS_K=0, LDS_V=NSLOT*SLOTB, LDS_WS=LDS_V+NVSLOT*VSLOTB, LDS_OST=LDS_WS+NW*64*4, LDS_BYTES=LDS_OST+NW*4096;
constexpr float C2=0.125f*1.4426950408889634f;
__device__ __forceinline__ void glds16(const void*gsrc,unsigned lds_dst){unsigned keep;
  asm volatile("s_mov_b32 %0, m0\n\ts_mov_b32 m0, %2\n\ts_nop 0\n\tglobal_load_lds_dwordx4 %1, off\n\ts_mov_b32 m0, %0":"=&s"(keep):"v"(gsrc),"s"(lds_dst):"memory");}
__device__ __forceinline__ float max3f(float a,float b,float c){float r;asm("v_max3_f32 %0, %1, %2, %3":"=v"(r):"v"(a),"v"(b),"v"(c));return r;}
__device__ __forceinline__ float max2f(float a,float b){float r;asm("v_max_f32_e32 %0, %1, %2":"=v"(r):"v"(a),"v"(b));return r;}
__device__ __forceinline__ float fadd_s(float a,float b){float r;asm("v_add_f32_e32 %0, %1, %2":"=v"(r):"v"(a),"v"(b));return r;}
__device__ __forceinline__ float fsub_s(float a,float b){float r;asm("v_sub_f32_e32 %0, %1, %2":"=v"(r):"v"(a),"v"(b));return r;}
typedef float f32x2_t __attribute__((ext_vector_type(2))); typedef __bf16 bf16x2_t __attribute__((ext_vector_type(2)));
__device__ __forceinline__ unsigned cvtpk_s(float lo,float hi){f32x2_t v={lo,hi};bf16x2_t b=__builtin_convertvector(v,bf16x2_t);return __builtin_bit_cast(unsigned,b);}
#define WAIT_BAR(N) asm volatile("s_waitcnt vmcnt(" #N ") lgkmcnt(0)\n\ts_barrier":::"memory")

__device__ __forceinline__ void qkt(f32x16&p0,f32x16&p1,const char*Kslot,const bf16x8*qr,const f32x16&ci0,const f32x16&ci1,int r32,int hi){
  const char*kb=Kslot+hi*1024+r32*16;
  #pragma unroll
  for(int d0=0;d0<4;++d0){
    const bf16x8 b0=*reinterpret_cast<const bf16x8*>(kb+d0*2048);
    const bf16x8 b1=*reinterpret_cast<const bf16x8*>(kb+d0*2048+512);
    if(d0==0){p0=__builtin_amdgcn_mfma_f32_32x32x16_bf16(b0,qr[0],ci0,0,0,0);p1=__builtin_amdgcn_mfma_f32_32x32x16_bf16(b1,qr[0],ci1,0,0,0);}
    else{p0=__builtin_amdgcn_mfma_f32_32x32x16_bf16(b0,qr[d0],p0,0,0,0);p1=__builtin_amdgcn_mfma_f32_32x32x16_bf16(b1,qr[d0],p1,0,0,0);}}
}
typedef __attribute__((address_space(3))) const char* lds_cptr;
typedef short v4i16_t __attribute__((ext_vector_type(4)));
__device__ __forceinline__ void kload8(bf16x8*kf,lds_cptr kp){
  kf[0]=*(const __attribute__((address_space(3))) bf16x8*)(kp);      kf[1]=*(const __attribute__((address_space(3))) bf16x8*)(kp+512);
  kf[2]=*(const __attribute__((address_space(3))) bf16x8*)(kp+2048); kf[3]=*(const __attribute__((address_space(3))) bf16x8*)(kp+2560);
  kf[4]=*(const __attribute__((address_space(3))) bf16x8*)(kp+4096); kf[5]=*(const __attribute__((address_space(3))) bf16x8*)(kp+4608);
  kf[6]=*(const __attribute__((address_space(3))) bf16x8*)(kp+6144); kf[7]=*(const __attribute__((address_space(3))) bf16x8*)(kp+6656);
}
__device__ __forceinline__ void kload2(bf16x8*kf,lds_cptr kp,int j){ kf[2*j]=*(const __attribute__((address_space(3))) bf16x8*)(kp+j*2048); kf[2*j+1]=*(const __attribute__((address_space(3))) bf16x8*)(kp+j*2048+512); }
__device__ __forceinline__ s16x4 vtr(lds_cptr p){ return __builtin_bit_cast(s16x4,__builtin_amdgcn_ds_read_tr16_b64_v4i16((__attribute__((address_space(3))) v4i16_t*)p)); }
__device__ __forceinline__ float rowmax(const f32x16&p0,const f32x16&p1){
  float a=max3f(p0[0],p0[1],p1[0]),b=max3f(p0[2],p0[3],p1[1]);a=max3f(a,p1[2],p1[3]);
  #pragma unroll
  for(int r=4;r<16;r+=4){a=max3f(a,p0[r],p0[r+1]);b=max3f(b,p0[r+2],p0[r+3]);a=max3f(a,p1[r],p1[r+1]);b=max3f(b,p1[r+2],p1[r+3]);}
  const float m=max2f(a,b);
  auto rr=__builtin_amdgcn_permlane32_swap(__float_as_uint(m),__float_as_uint(m),false,false);
  return max2f(__uint_as_float(rr[0]),__uint_as_float(rr[1]));
}
__device__ __forceinline__ void pv(f32x16*o,int vb,bf16x8 pa0,bf16x8 pa1,bf16x8 pa2,bf16x8 pa3){
  #pragma unroll
  for(int d0=0;d0<4;++d0){s16x4 lo[4],hi[4];
    #pragma unroll
    for(int ks=0;ks<4;++ks){
      asm volatile("ds_read_b64_tr_b16 %0,%1 offset:%c2":"=&v"(lo[ks]):"v"(vb),"i"(d0*4096+ks*1024):"memory");
      asm volatile("ds_read_b64_tr_b16 %0,%1 offset:%c2":"=&v"(hi[ks]):"v"(vb),"i"(d0*4096+ks*1024+512):"memory");}
    asm volatile("s_waitcnt lgkmcnt(0)":::"memory");SBAR();
    #define PK(k) (bf16x8){lo[k][0],lo[k][1],lo[k][2],lo[k][3],hi[k][0],hi[k][1],hi[k][2],hi[k][3]}
    o[d0]=__builtin_amdgcn_mfma_f32_32x32x16_bf16(pa0,PK(0),o[d0],0,0,0);
    o[d0]=__builtin_amdgcn_mfma_f32_32x32x16_bf16(pa1,PK(1),o[d0],0,0,0);
    o[d0]=__builtin_amdgcn_mfma_f32_32x32x16_bf16(pa2,PK(2),o[d0],0,0,0);
    o[d0]=__builtin_amdgcn_mfma_f32_32x32x16_bf16(pa3,PK(3),o[d0],0,0,0);
    #undef PK
  }
}

#ifndef ATTN_STORE16
#define ATTN_STORE16(p,v) do{ asm volatile("global_store_dwordx4 %0, %1, off sc0 sc1\n\ts_nop 1"::"v"(p),"v"(v):"memory"); }while(0)
#endif
template<int THRL> __device__ __forceinline__ void attn_unit(int b,int hq,int hv,int ho,int qb,const bf16*Q,const bf16*__restrict__ K,const bf16*__restrict__ V,bf16*O,char*shm,lds_fptr btab){
  int tid_=threadIdx.x; asm volatile("":"+v"(tid_)); const int tid=tid_,lane=tid&63,r32=lane&31,hi=lane>>5; const int wid=__builtin_amdgcn_readfirstlane(tid>>6);
  const long rowbase=(long)b*SEQ; const int q0=qb*QB;
  const bf16*Qw=Q+(rowbase+q0+wid*QBLK)*DM+hq*D;
  const bf16*Kh=K+rowbase*DM+hq*D,*Vh=V+rowbase*DM+hv*D;
  const unsigned lds0=(unsigned)(uintptr_t)shm;
  float*wsf=(float*)(shm+LDS_WS)+wid*64;
  const bf16*ksrc=Kh+(long)lane*DM+wid*8;
  const bf16*vsrc=Vh+(long)(16*(wid&3)+(lane>>2))*DM+(wid>>2)*32+(lane&3)*8;
  const unsigned kdst=lds0+LDS_K+wid*1024, vdst=lds0+LDS_V+wid*1024;
  #define DMA_K(t,slot) glds16(ksrc+(long)(t)*KVBLK*DM,(unsigned)__builtin_amdgcn_readfirstlane(kdst+(slot)))
  #define VSL(t) ((((t))&(NVSLOT-1))*VSLOTB)
  #define DMA_V(t) do{ glds16(vsrc+(long)(t)*KVBLK*DM,(unsigned)__builtin_amdgcn_readfirstlane(vdst+VSL(t))); glds16(vsrc+(long)(t)*KVBLK*DM+64,(unsigned)__builtin_amdgcn_readfirstlane(vdst+VSL(t)+8192)); }while(0)
  const int vb0=(int)(lds0+LDS_V)+((lane>>4)&1)*32+(lane&3)*8+(4*hi+((lane&15)>>2))*64;
  const char*Kbase=shm+LDS_K; bf16x8 kf[8];
  const lds_cptr shm3=(lds_cptr)shm; const lds_cptr kp0=shm3+LDS_K+hi*1024+r32*16; const lds_cptr vp0=shm3+LDS_V+((lane>>4)&1)*32+(lane&3)*8+(4*hi+((lane&15)>>2))*64;
  const int NT=(q0+QB)/KVBLK;
  DMA_K(0,0);DMA_V(0);DMA_K(1,SLOTB);
  bf16x8 qr[4];
  #pragma unroll
  for(int d0=0;d0<4;++d0)qr[d0]=*reinterpret_cast<const bf16x8*>(&Qw[(long)r32*DM+d0*16+hi*8]);
  float mhat=0.f,l_reg=0.f;f32x16 o[4];o[0]=f32x16{};o[1]=f32x16{};o[2]=f32x16{};o[3]=f32x16{};f32x16 negm=f32x16{};asm volatile("":"+v"(negm));
  const int qrel=wid*QBLK+r32;
  #define CMASK(P0,P1,t) do{int jb_=(t)-(NT-4); if(jb_>=0)cmask(P0,P1,jb_,qrel,hi);}while(0)
  bool resc=false;
  #define START(P0,P1) do{ const float rm=rowmax(P0,P1); resc=false; \
    { const float dl=rm; mhat=fadd_s(mhat,dl); \
      _Pragma("unroll") for(int r=0;r<16;++r){P0[r]=fsub_s(P0[r],dl);P1[r]=fsub_s(P1[r],dl);} \
      _Pragma("unroll") for(int r=0;r<16;++r)negm[r]=-mhat; asm volatile("":"+v"(negm)); } \
    _Pragma("unroll") for(int r=0;r<16;++r)P0[r]=__builtin_amdgcn_exp2f(P0[r]); }while(0)
  #define RESC() do{ if(resc){ asm volatile("s_waitcnt lgkmcnt(0)":::"memory"); \
      _Pragma("unroll") for(int d_=0;d_<4;++d_) _Pragma("unroll") for(int r=0;r<16;++r)o[d_][r]*=wsf[crow(r,hi)]; } }while(0)
  f32x16 pA0,pA1;
  int sl_prev=0,sl_cur=0,sl_next=SLOTB;
  #define ROT() do{sl_prev=sl_cur;sl_cur=sl_next;sl_next=(sl_next==(NSLOT-1)*SLOTB)?0:sl_next+SLOTB;}while(0)
  DMA_K(2,2*SLOTB);DMA_V(1);
  WAIT_BAR(6);
  if(NT==4){ f32x16 cb0,cb1; bias_init1(cb0,0,0,qrel,hi,btab,negm); bias_init1(cb1,1,0,qrel,hi,btab,negm); qkt(pA0,pA1,Kbase,qr,cb0,cb1,r32,hi); } else qkt(pA0,pA1,Kbase,qr,negm,negm,r32,hi);
  asm volatile("s_nop 15\n\ts_nop 7":"+v"(pA0),"+v"(pA1));CMASK(pA0,pA1,0);
  START(pA0,pA1);
  _Pragma("unroll") for(int r=0;r<16;++r)pA1[r]=__builtin_amdgcn_exp2f(pA1[r]);
  u32x4 pw0,pw1,pw2,pw3;
  #define PKW(P,B) cvtpk_s(P[B],P[B+1])
  { float sacc=pA0[0]+pA0[1]; _Pragma("unroll") for(int r=2;r<16;++r)sacc+=pA0[r]; _Pragma("unroll") for(int r=0;r<16;++r)sacc+=pA1[r]; l_reg+=sacc;
    pw0=(u32x4){PKW(pA0,0),PKW(pA0,2),PKW(pA0,4),PKW(pA0,6)};pw1=(u32x4){PKW(pA0,8),PKW(pA0,10),PKW(pA0,12),PKW(pA0,14)};pw2=(u32x4){PKW(pA1,0),PKW(pA1,2),PKW(pA1,4),PKW(pA1,6)};pw3=(u32x4){PKW(pA1,8),PKW(pA1,10),PKW(pA1,12),PKW(pA1,14)}; }
  WAIT_BAR(3);
  DMA_K(3,0);DMA_V(2);
  ROT();
  kload8(kf,kp0+sl_cur);
  WAIT_BAR(5);
  s16x4 vlo[4],vhi[4];
  #define PAF(k) __builtin_bit_cast(bf16x8,pw##k)
  #define VFR(i) (bf16x8){vlo[i][0],vlo[i][1],vlo[i][2],vlo[i][3],vhi[i][0],vhi[i][1],vhi[i][2],vhi[i][3]}
  #define PIN(x) asm volatile("":"+v"(x))
  #define MX3(a,b,c) __builtin_fmaxf(__builtin_fmaxf((a),(b)),(c))
  #define EX(v) __builtin_amdgcn_exp2f(v)
  #define VRD(f) do{ vlo[(f)&3]=vtr(vp_+(((f)&3)*4096+((f)>>2)*1024)); vhi[(f)&3]=vtr(vp_+(((f)&3)*4096+((f)>>2)*1024+512)); }while(0)
  #define KRD(G,j) do{ if(G){ kload2(kf,kp0+sl_next,j); } }while(0)
  #define GAPQ(MF) do{ MF; SBAR(); }while(0)
  #define GAPB(MF,X,B,EXTRA) do{ MF; X[B]=EX(X[B]); X[B+1]=EX(X[B+1]); sacc+=X[B]; sacc+=X[B+1]; EXTRA; PIN(X); PIN(sacc); SBAR(); }while(0)
  #define PVM(j) o[(j)&3]=__builtin_amdgcn_mfma_f32_32x32x16_bf16(PAFJ(j),VFR((j)&3),o[(j)&3],0,0,0)
  #define STEP(C0,C1,t,GK,GV,GL,BZ) do{ SBAR(); \
    const lds_cptr vp_=vp0+VSL((t)-1); \
    if(BZ){ bias_init1(C0,0,(t)-(NT-4),qrel,hi,btab,negm); SBAR(); } \
    GAPQ(C0=__builtin_amdgcn_mfma_f32_32x32x16_bf16(kf[0],qr[0],(BZ)?C0:negm,0,0,0)); \
    if(BZ){ bias_init1(C1,1,(t)-(NT-4),qrel,hi,btab,negm); SBAR(); } \
    GAPQ(C1=__builtin_amdgcn_mfma_f32_32x32x16_bf16(kf[1],qr[0],(BZ)?C1:negm,0,0,0)); \
    GAPQ(C0=__builtin_amdgcn_mfma_f32_32x32x16_bf16(kf[2],qr[1],C0,0,0,0)); \
    GAPQ(C1=__builtin_amdgcn_mfma_f32_32x32x16_bf16(kf[3],qr[1],C1,0,0,0)); \
    VRD(0); SBAR(); GAPQ(C0=__builtin_amdgcn_mfma_f32_32x32x16_bf16(kf[4],qr[2],C0,0,0,0)); \
    VRD(1); SBAR(); GAPQ(C1=__builtin_amdgcn_mfma_f32_32x32x16_bf16(kf[5],qr[2],C1,0,0,0)); \
    VRD(2); SBAR(); GAPQ(C0=__builtin_amdgcn_mfma_f32_32x32x16_bf16(kf[6],qr[3],C0,0,0,0)); \
    VRD(3); SBAR(); GAPQ(C1=__builtin_amdgcn_mfma_f32_32x32x16_bf16(kf[7],qr[3],C1,0,0,0)); \
    if(GK){DMA_K((t)+3,sl_cur);} if(GV){DMA_V((t)+2);} \
    CMASK(C0,C1,t); \
    { float a=MX3(C0[0],C0[1],C1[0]),b=MX3(C0[2],C0[3],C1[1]); a=MX3(a,C1[2],C1[3]); \
      _Pragma("unroll") for(int r=4;r<16;r+=4){a=MX3(a,C0[r],C0[r+1]);b=MX3(b,C0[r+2],C0[r+3]);a=MX3(a,C1[r],C1[r+1]);b=MX3(b,C1[r+2],C1[r+3]);} \
      float rm=__builtin_fmaxf(a,b); { auto rr=__builtin_amdgcn_permlane32_swap(__float_as_uint(rm),__float_as_uint(rm),false,false); rm=__builtin_fmaxf(__uint_as_float(rr[0]),__uint_as_float(rr[1])); } \
      resc=false; \
      if(__builtin_expect(__any(rm>(float)THRL),0)){ const float dl=__builtin_fmaxf(rm,0.f); mhat+=dl; \
        _Pragma("unroll") for(int r=0;r<16;++r){C0[r]-=dl;C1[r]-=dl;} \
        _Pragma("unroll") for(int r=0;r<16;++r)negm[r]=-mhat; asm volatile("":"+v"(negm)); \
        const float f=__builtin_amdgcn_exp2f(-dl); l_reg*=f; if(hi==0)wsf[r32]=f; resc=true; } } \
    SBAR(); float sacc=0.f; \
    GAPB(PVM(0),  C0,0,  VRD(4)); \
    GAPB(PVM(1),  C0,2,  VRD(5)); \
    GAPB(PVM(2),  C0,4,  VRD(6)); \
    GAPB(PVM(3),  C0,6,  VRD(7)); \
    GAPB(PVM(4),  C0,8,  VRD(8);  pw0[0]=PKW(C0,0); pw0[1]=PKW(C0,2); PIN(pw0)); \
    GAPB(PVM(5),  C0,10, VRD(9);  pw0[2]=PKW(C0,4); pw0[3]=PKW(C0,6); PIN(pw0)); \
    GAPB(PVM(6),  C0,12, VRD(10)); \
    GAPB(PVM(7),  C0,14, VRD(11)); \
    GAPB(PVM(8),  C1,0,  VRD(12); pw1[0]=PKW(C0,8);  pw1[1]=PKW(C0,10); PIN(pw1)); \
    GAPB(PVM(9),  C1,2,  VRD(13); pw1[2]=PKW(C0,12); pw1[3]=PKW(C0,14); PIN(pw1)); \
    GAPB(PVM(10), C1,4,  VRD(14); KRD(GL,0)); \
    GAPB(PVM(11), C1,6,  VRD(15); KRD(GL,1)); \
    GAPB(PVM(12), C1,8,  KRD(GL,2); pw2[0]=PKW(C1,0); pw2[1]=PKW(C1,2); PIN(pw2)); \
    GAPB(PVM(13), C1,10, KRD(GL,3); pw2[2]=PKW(C1,4); pw2[3]=PKW(C1,6); PIN(pw2)); \
    GAPB(PVM(14), C1,12, (void)0); \
    GAPB(PVM(15), C1,14, (void)0); \
    pw3=(u32x4){PKW(C1,8),PKW(C1,10),PKW(C1,12),PKW(C1,14)}; l_reg+=sacc; \
    }while(0)
  #define PAFJ(j) PAFJ_((j)>>2)
  #define PAFJ_(k) ((k)==0?PAF(0):(k)==1?PAF(1):(k)==2?PAF(2):PAF(3))
  int t=1;
  #undef CMASK
  #define CMASK(P0,P1,t) do{}while(0)
  for(;t+7<NT;t+=2){
    STEP(pA0,pA1,t,true,true,true,0);     WAIT_BAR(5); RESC(); ROT();
    STEP(pA0,pA1,t+1,true,true,true,0);   WAIT_BAR(5); RESC(); ROT();
  }
  #undef CMASK
  #define CMASK(P0,P1,t) do{int jb_=(t)-(NT-4); if(jb_>=0)cmask(P0,P1,jb_,qrel,hi);}while(0)
  #define ENDW(tt) do{ if((tt)+3<NT){WAIT_BAR(5);} else if((tt)+2<NT){WAIT_BAR(4);} else {WAIT_BAR(0);} }while(0)
  for(;t+1<NT;t+=2){
    STEP(pA0,pA1,t,(t+3<NT),(t+2<NT),(t+1<NT),1);       ENDW(t);   RESC(); ROT();
    STEP(pA0,pA1,t+1,(t+4<NT),(t+3<NT),(t+2<NT),1);     ENDW(t+1); RESC(); ROT();
  }
  STEP(pA0,pA1,NT-1,false,false,false,1); RESC();
  { SBAR(); pv(o,vb0+VSL(NT-1),PAF(0),PAF(1),PAF(2),PAF(3)); }
  #undef PKW
  #undef PAF
  #undef VFR
  #undef PIN
  #undef MX3
  #undef GAPQ
  #undef PVM
  #undef PAFJ
  #undef PAFJ_
  #undef GAPB
  #undef EX
  #undef VRD
  #undef KRD
  #undef STEP
  #undef ENDW
  {auto rr=__builtin_amdgcn_permlane32_swap(__float_as_uint(l_reg),__float_as_uint(l_reg),false,false);l_reg=__uint_as_float(rr[0])+__uint_as_float(rr[1]);}
  if(hi==0)wsf[32+r32]=l_reg;asm volatile("s_waitcnt lgkmcnt(0)":::"memory");
  float rli[16];
  #pragma unroll
  for(int r=0;r<16;++r)rli[r]=__builtin_amdgcn_rcpf(wsf[32+crow(r,hi)]);
  bf16*Ow=O+(rowbase+q0+wid*QBLK)*OPITCH+ho*D;
  { bf16*stg=(bf16*)(shm+LDS_OST)+wid*2048;
    #pragma unroll
    for(int ps=0;ps<2;++ps){
      #pragma unroll
      for(int r=0;r<16;++r){const int orow=crow(r,hi);
        #pragma unroll
        for(int d0=0;d0<2;++d0)stg[orow*64+d0*32+r32]=__float2bfloat16(o[2*ps+d0][r]*rli[r]);}
      asm volatile("s_waitcnt lgkmcnt(0)":::"memory");
      #pragma unroll
      for(int i=0;i<4;++i){const int row=i*8+(lane>>3),ch=lane&7; const u32x4 v=*(const u32x4*)(stg+row*64+ch*8); ATTN_STORE16(Ow+(long)row*OPITCH+ps*64+ch*8,v);}
      asm volatile("s_waitcnt lgkmcnt(0)":::"memory"); } }
  asm volatile("s_waitcnt lgkmcnt(0)\n\ts_barrier":::"memory");
  #undef DMA_K
  #undef DMA_V
  #undef VSL
  #undef CMASK
  #undef START
  #undef RESC
  #undef ROT
}
constexpr int ATTN_LDS_BYTES=LDS_BYTES;
constexpr int BTAB_OFF=126976;
struct AttnTensors { const bf16* Q; const bf16* K; const bf16* V; bf16* O; };
struct AttnCombine { float lam, lam_init; const float* gain; bf16* ab; };
__device__ __forceinline__ void combine_block(const AttnCombine&C,const bf16*O,int b,int h,int qb){
  typedef unsigned u32x4c __attribute__((ext_vector_type(4)));
  int tid_=threadIdx.x; asm volatile("":"+v"(tid_)); const int lane=tid_&63; const int wid=__builtin_amdgcn_readfirstlane(tid_>>6);
  const int e0=(lane&7)*16; const long row0=(long)b*SEQ+qb*QB+wid*QBLK+(lane>>3);
  asm volatile("s_waitcnt vmcnt(0)":::"memory");
  u32x4c a0[4],a1[4],b0[4],b1[4];
  #pragma unroll
  for(int it=0;it<4;++it){ const bf16*p=O+(row0+8*it)*OPITCH+h*256+e0;
    a0[it]=*(const u32x4c*)p; a1[it]=*(const u32x4c*)(p+8); b0[it]=*(const u32x4c*)(p+128); b1[it]=*(const u32x4c*)(p+136); }
  float g[16];
  #pragma unroll
  for(int i=0;i<16;++i)g[i]=C.gain[e0+i];
  #pragma unroll
  for(int it=0;it<4;++it){ float o[16]; float ss=0.f;
    #pragma unroll
    for(int i=0;i<4;++i){
      o[2*i]=__uint_as_float(a0[it][i]<<16)-C.lam*__uint_as_float(b0[it][i]<<16); o[2*i+1]=__uint_as_float(a0[it][i]&0xffff0000u)-C.lam*__uint_as_float(b0[it][i]&0xffff0000u);
      o[8+2*i]=__uint_as_float(a1[it][i]<<16)-C.lam*__uint_as_float(b1[it][i]<<16); o[8+2*i+1]=__uint_as_float(a1[it][i]&0xffff0000u)-C.lam*__uint_as_float(b1[it][i]&0xffff0000u); }
    #pragma unroll
    for(int i=0;i<16;++i)ss+=o[i]*o[i];
    ss+=__shfl_xor(ss,1); ss+=__shfl_xor(ss,2); ss+=__shfl_xor(ss,4);
    const float r=__builtin_amdgcn_rsqf(ss*(1.0f/128.0f)+1e-6f)*(1.0f-C.lam_init);
    u32x4c w0,w1;
    #pragma unroll
    for(int i=0;i<4;++i){ w0[i]=cvtpk_s(o[2*i]*r*g[2*i],o[2*i+1]*r*g[2*i+1]); w1[i]=cvtpk_s(o[8+2*i]*r*g[8+2*i],o[8+2*i+1]*r*g[8+2*i+1]); }
    bf16*q=C.ab+(row0+8*it)*1024+h*128+e0; *(u32x4c*)q=w0; *(u32x4c*)(q+8)=w1; }
}
template<int THRL=8> __device__ __forceinline__ void attn_phase(char*lds,const AttnTensors&T,int vcu,int G,const float*btab_g,const AttnCombine&C){
  float*bt=(float*)(lds+BTAB_OFF); const lds_fptr bt3=(lds_fptr)(lds_cptr)lds+BTAB_OFF/4;
  for(int c=vcu;c<256;c+=G){
    const int xc_=c&7,jc_=c>>3, bh_=(G==256)?(xc_*8+(jc_>>2)):(c>>2), qt=(G==256)?(jc_&3):(c&3), b=bh_>>3,h=bh_&7;
    for(int i=threadIdx.x;i<768;i+=512){const int d=i-256; bt[i]=(d>=0&&d<128)?btab_g[h*128+d]:0.f;}
    __syncthreads();
    #pragma unroll 1
    for(int qi=0;qi<4;++qi){ const int qb=(qi>>1)?qt:7-qt, m=qi&1;
      attn_unit<THRL>(b,2*h+m,2*h,4*h+2*m,qb,T.Q,T.K,T.V,T.O,lds,bt3);
      if(m)combine_block(C,T.O,b,h,qb); }
    __syncthreads();
  }
}
#undef SBAR
#undef WAIT_BAR
}
#define GAS __attribute__((address_space(1)))
#define LAS __attribute__((address_space(3)))
typedef unsigned short bf16;
typedef unsigned v4u __attribute__((ext_vector_type(4)));
typedef float f32x4 __attribute__((ext_vector_type(4)));
typedef short bf16x8 __attribute__((ext_vector_type(8)));
typedef GAS unsigned gu32;
typedef GAS unsigned long long gu64;
#define RLX_AGENT __ATOMIC_RELAXED, __HIP_MEMORY_SCOPE_AGENT
#define LDS_WAIT() asm volatile("s_waitcnt lgkmcnt(0)" ::: "memory")
#define VM_WAIT() asm volatile("s_waitcnt vmcnt(0)" ::: "memory")
__device__ __forceinline__ unsigned long long rt() { return __builtin_amdgcn_s_memrealtime(); }
__device__ __forceinline__ unsigned f2bf(float f) { unsigned u = __builtin_bit_cast(unsigned, f); return (u + 0x7fffu + ((u >> 16) & 1u)) >> 16; }
__device__ __forceinline__ unsigned pk2(float lo, float hi) { return f2bf(lo) | (f2bf(hi) << 16); }

#define XB_TMO      128
#define XB_XCNT(j)  (256  + 64 * (j))
#define XB_XSUB(j)  (1280 + 64 * (j))
#define XB_XGEN(j)  (2304 + 64 * (j))
#define XB_TOP      3328
#define XB_TOPGEN   3392
#define XCD_BAR_WORDS 3456
#define XB_SPIN_CAP (1u << 18)

__device__ __forceinline__ unsigned xb_ld(unsigned* p)              { return __hip_atomic_load(p, __ATOMIC_RELAXED, __HIP_MEMORY_SCOPE_AGENT); }
__device__ __forceinline__ unsigned xb_add(unsigned* p, unsigned v) { return __hip_atomic_fetch_add(p, v, __ATOMIC_RELAXED, __HIP_MEMORY_SCOPE_AGENT); }
__device__ __forceinline__ unsigned xb_xcc_id() { return (unsigned)__builtin_amdgcn_s_getreg((3 << 11) | 20) & 0xFu; }
#define XB_SPIN(cond, bar) do { unsigned _sp = 0; while (cond) { __builtin_amdgcn_s_sleep(1); \
    if ((++_sp & 255u) == 0u) { if (xb_ld(&(bar)[XB_TMO])) break; if (_sp > XB_SPIN_CAP) { atomicAdd(&(bar)[XB_TMO], 1u); break; } } } } while (0)

struct XcdBarrier {
    unsigned* bar; unsigned x;
    volatile LAS unsigned* st;
};

__device__ __forceinline__ XcdBarrier xcd_barrier_post(unsigned* bar, volatile LAS unsigned* st) {
    XcdBarrier b; b.bar = bar; b.x = xb_xcc_id(); b.st = st;
    if (threadIdx.x == 0) (void)xb_add(&bar[XB_XCNT(b.x)], 1u);
    return b;
}
__device__ __forceinline__ void xcd_barrier_complete(unsigned* bar, unsigned x, unsigned& nloc, unsigned& nx) {
    const unsigned G = gridDim.x * gridDim.y * gridDim.z;
    unsigned sum, cnt, mine, sp = 0u;
    for (;;) {
        sum = 0u; cnt = 0u; mine = 0u;
#pragma unroll
        for (unsigned j = 0; j < 16; ++j) { const unsigned c = xb_ld(&bar[XB_XCNT(j)]); sum += c; cnt += (c > 0u) ? 1u : 0u; mine = (j == x) ? c : mine; }
        if (sum == G) break;
        __builtin_amdgcn_s_sleep(1);
        if ((++sp & 255u) == 0u) { if (xb_ld(&bar[XB_TMO])) break; if (sp > XB_SPIN_CAP) { atomicAdd(&bar[XB_TMO], 1u); break; } }
    }
    nloc = mine > 0u ? mine : 1u; nx = cnt > 0u ? cnt : 1u;
}

__device__ __forceinline__ void xcd_barrier(const XcdBarrier& b) {
    asm volatile("s_waitcnt vmcnt(0)" ::: "memory");
    __syncthreads();
    if (threadIdx.x == 0) {
        unsigned* bar = b.bar; unsigned bx_ = b.x; asm volatile("" : "+s"(bar), "+s"(bx_));
        __builtin_amdgcn_s_waitcnt(0);
        unsigned nloc = b.st[0], nx = b.st[1];
        if (nloc == 0u) { xcd_barrier_complete(bar, bx_, nloc, nx); b.st[0] = nloc; b.st[1] = nx; }
        const unsigned old = xb_add(&bar[XB_XSUB(bx_)], 1u);
        const unsigned gen = old / nloc;
        if (old + 1u == (gen + 1u) * nloc) {
            __builtin_amdgcn_fence(__ATOMIC_RELEASE, "agent");
            asm volatile("s_waitcnt vmcnt(0)" ::: "memory");
            const unsigned og = xb_add(&bar[XB_TOP], 1u);
            const unsigned tg = og / nx;
            if (og + 1u == (tg + 1u) * nx) xb_add(&bar[XB_TOPGEN], 1u);
            else XB_SPIN(xb_ld(&bar[XB_TOPGEN]) == tg, bar);
            __builtin_amdgcn_fence(__ATOMIC_ACQUIRE, "agent");
            xb_add(&bar[XB_XGEN(bx_)], 1u);
            asm volatile("s_waitcnt vmcnt(0)" ::: "memory");
        } else {
            XB_SPIN(xb_ld(&bar[XB_XGEN(bx_)]) == gen, bar);
            __builtin_amdgcn_fence(__ATOMIC_ACQUIRE, "agent");
            asm volatile("s_waitcnt vmcnt(0)" ::: "memory");
        }
    }
    __syncthreads();
}

struct Frame {
    LAS unsigned char* lds; volatile LAS unsigned* MISC; gu32* ctl;
    int tid, lane, wave, vcu, G;
    float* out; unsigned char* ws;
};
struct Args { const float* in[25]; float* out; unsigned char* ws; int ph_lo, ph_hi, li, pad; };
__device__ __forceinline__ const float* ldin(const Args& a, int k) { int z; asm volatile("s_mov_b32 %0, 0" : "=s"(z)); return a.in[k + z]; }
#define IN(k) ldin(args, (k))
__device__ __forceinline__ float wave_sum(float v) {
#pragma unroll
    for (int o = 1; o < 64; o <<= 1) v += __shfl_xor(v, o);
    return v;
}
__device__ __forceinline__ float wave_max(float v) {
#pragma unroll
    for (int o = 1; o < 64; o <<= 1) v = fmaxf(v, __shfl_xor(v, o));
    return v;
}
__device__ __forceinline__ float wave_total(float v) {
    int x = __builtin_bit_cast(int, v);
#define DPPADD(ctrl, rm, bc) x = __builtin_bit_cast(int, __builtin_bit_cast(float, x) + __builtin_bit_cast(float, __builtin_amdgcn_update_dpp(0, x, ctrl, rm, 0xF, bc)))
    DPPADD(0xB1, 0xF, true); DPPADD(0x4E, 0xF, true); DPPADD(0x141, 0xF, true); DPPADD(0x140, 0xF, true); DPPADD(0x142, 0xA, false); DPPADD(0x143, 0xC, false);
#undef DPPADD
    return __builtin_bit_cast(float, __builtin_amdgcn_readlane(x, 63));
}
__device__ __forceinline__ float bf_lo(unsigned w) { return __uint_as_float(w << 16); }
__device__ __forceinline__ float bf_hi(unsigned w) { return __uint_as_float(w & 0xffff0000u); }
__device__ __forceinline__ float gelu_tanh_f(float x) { const float y = 0.7978845608028654f * (x + 0.044715f * x * x * x); return x * __builtin_amdgcn_rcpf(1.0f + __builtin_amdgcn_exp2f(-2.0f * LOG2E * y)); }

__device__ __forceinline__ void p0_transpose_item(const float* W, int Nsrc, int n0, const float* gain, bf16* WT, int dst_row0, int kb, LAS float* scr, int lane) {
    const int k0 = 64 * kb;
    f32x4 wv[8];
#pragma unroll
    for (int i = 0; i < 8; ++i) wv[i] = *(const GAS f32x4*)(W + (size_t)(k0 + 8 * i + (lane >> 3)) * Nsrc + n0 + 4 * (lane & 7));
#pragma unroll
    for (int i = 0; i < 8; ++i) { const int kk = 8 * i + (lane >> 3); const float g = gain ? gain[k0 + kk] : 1.0f; LAS float* d = scr + kk * 33 + 4 * (lane & 7);
        d[0] = wv[i][0] * g; d[1] = wv[i][1] * g; d[2] = wv[i][2] * g; d[3] = wv[i][3] * g; }
    LDS_WAIT(); asm volatile("" ::: "memory");
    const int c = lane & 7;
#pragma unroll
    for (int j = 0; j < 4; ++j) { const int n = (lane >> 3) + 8 * j; const LAS float* s = scr + (8 * c) * 33 + n;
        v4u o; o.x = pk2(s[0 * 33], s[1 * 33]); o.y = pk2(s[2 * 33], s[3 * 33]); o.z = pk2(s[4 * 33], s[5 * 33]); o.w = pk2(s[6 * 33], s[7 * 33]);
        *(GAS v4u*)(WT + (size_t)(dst_row0 + n) * 1024 + k0 + 8 * c) = o; }
    LDS_WAIT(); asm volatile("" ::: "memory");
}
__device__ __forceinline__ int p0_src_col(int type, int dst_nb) {
    const int tile = dst_nb >> 3, g = dst_nb & 7, bj = g >> 2, wc = g & 3;
    if (type == 1) return tile * 256 + (2 * wc + bj) * 32;
    if (type == 2 && tile >= 4) return (bj ? 2048 : 1024) + 128 * (tile - 4) + 32 * wc;
    return 32 * dst_nb;
}
__device__ __forceinline__ int rel_bucket(int n) {
    if (n < 16) return n;
    const int large = 16 + (int)(logf((float)n / 16.0f) / 2.0794415416798357f * 16.0f);
    return large < 31 ? large : 31;
}
__device__ __forceinline__ void quant_row_store(unsigned char* ws, int tab, int rr, const f32x4 (&v)[4], int lane) {
    float mx = 0.f;
#pragma unroll
    for (int i = 0; i < 4; ++i) mx = fmaxf(mx, fmaxf(fmaxf(fabsf(v[i][0]), fabsf(v[i][1])), fmaxf(fabsf(v[i][2]), fabsf(v[i][3]))));
    mx = wave_max(mx);
    const bool f4 = tab == 0 ? UF4 : VF4; const float top = f4 ? 6.0f : 440.0f;
    const float sc = mx > 0.f ? top / mx : 1.0f, isc = mx > 0.f ? mx / top : 1.0f;
    if (f4) { unsigned w0 = 0u, w1 = 0u;
        w0 = __builtin_amdgcn_cvt_scalef32_pk_fp4_f32(w0, v[0][0] * sc, v[0][1] * sc, 1.0f, 0); w0 = __builtin_amdgcn_cvt_scalef32_pk_fp4_f32(w0, v[0][2] * sc, v[0][3] * sc, 1.0f, 1);
        w0 = __builtin_amdgcn_cvt_scalef32_pk_fp4_f32(w0, v[1][0] * sc, v[1][1] * sc, 1.0f, 2); w0 = __builtin_amdgcn_cvt_scalef32_pk_fp4_f32(w0, v[1][2] * sc, v[1][3] * sc, 1.0f, 3);
        w1 = __builtin_amdgcn_cvt_scalef32_pk_fp4_f32(w1, v[2][0] * sc, v[2][1] * sc, 1.0f, 0); w1 = __builtin_amdgcn_cvt_scalef32_pk_fp4_f32(w1, v[2][2] * sc, v[2][3] * sc, 1.0f, 1);
        w1 = __builtin_amdgcn_cvt_scalef32_pk_fp4_f32(w1, v[3][0] * sc, v[3][1] * sc, 1.0f, 2); w1 = __builtin_amdgcn_cvt_scalef32_pk_fp4_f32(w1, v[3][2] * sc, v[3][3] * sc, 1.0f, 3);
        *(GAS v2u*)(ws + (tab == 0 ? WS_U8 : WS_V8) + (size_t)rr * 512 + 8 * lane) = (v2u){w0, w1};
    } else { v4u o;
#pragma unroll
        for (int i = 0; i < 4; ++i) { int w = 0; w = __builtin_amdgcn_cvt_pk_fp8_f32(v[i][0] * sc, v[i][1] * sc, w, false); w = __builtin_amdgcn_cvt_pk_fp8_f32(v[i][2] * sc, v[i][3] * sc, w, true); o[i] = (unsigned)w; }
        *(GAS v4u*)(ws + (tab == 0 ? WS_U8 : WS_V8) + (size_t)rr * 1024 + 16 * lane) = o; }
    if (lane == 0) ((float*)(ws + (tab == 0 ? WS_SU : WS_SV)))[rr] = isc;
}
__device__ __forceinline__ void p0_prologue(Frame& F, const Args& args) {
    LAS float* scr = (LAS float*)(F.lds + RING_OFF + F.wave * 16384);
    const int gw = F.vcu * NWAVES + F.wave, NGW = F.G * NWAVES;
    unsigned char* ws = F.ws;
    {
        constexpr int NB[12] = {96, 96, 32, 32, 96, 32, 64, 32, 64, 64, 64, 64};
        int base = 0;
#pragma unroll
        for (int mi = 0; mi < 12; ++mi) {
            const float* W; int Nsrc, type; const float* gain; bf16* dst;
            if (mi < 2)       { W = IN(4) + (size_t)mi * 1024 * 3072; Nsrc = 3072; type = 1; gain = IN(2) + (mi == 0 ? 0 : 3) * 1024; dst = (bf16*)(ws + WS_WQKV) + (size_t)mi * 3072 * 1024; }
            else if (mi < 4)  { W = IN(12) + (size_t)(mi - 2) * 1024 * 1024; Nsrc = 1024; type = 0; gain = nullptr; dst = (bf16*)(ws + WS_WO) + (size_t)(mi - 2) * 1024 * 1024; }
            else if (mi == 4) { W = IN(13); Nsrc = 3072; type = 2; gain = IN(2) + 1 * 1024; dst = (bf16*)(ws + WS_CIN); }
            else if (mi == 5) { W = IN(15); Nsrc = 1024; type = 0; gain = nullptr; dst = (bf16*)(ws + WS_COUT); }
            else if (mi == 6) { W = IN(16); Nsrc = 2048; type = 0; gain = IN(2) + 2 * 1024; dst = (bf16*)(ws + WS_SIN); }
            else if (mi == 7) { W = IN(20); Nsrc = 1024; type = 0; gain = nullptr; dst = (bf16*)(ws + WS_SOUT); }
            else              { W = IN(21) + (size_t)(mi - 8) * 1024 * 2048; Nsrc = 2048; type = 1; gain = IN(3) + (mi - 8) * 1024; dst = (bf16*)(ws + WS_PWQ) + (size_t)(mi - 8) * 2048 * 1024; }
            const int nitems = NB[mi] * 16;
            for (int it = gw; it < nitems; it += NGW) { const int nb = it >> 4, kb = it & 15; p0_transpose_item(W, Nsrc, p0_src_col(type, nb), gain, dst, 32 * nb, kb, scr, F.lane); }
            base += nitems;
        }
        (void)base;
    }
    const int gt = F.vcu * (NWAVES * 64) + F.tid, NGT = F.G * NWAVES * 64;
    { const float* kin = IN(22); bf16* kout = (bf16*)(ws + WS_PKEY);
      for (int i = gt; i < 4 * 8 * 2 * 128 * 128 / 8; i += NGT) { const f32x4 a = *(const GAS f32x4*)(kin + (size_t)i * 8), b = *(const GAS f32x4*)(kin + (size_t)i * 8 + 4);
          v4u o; o.x = pk2(a[0], a[1]); o.y = pk2(a[2], a[3]); o.z = pk2(b[0], b[1]); o.w = pk2(b[2], b[3]); *(GAS v4u*)(kout + (size_t)i * 8) = o; }
      const float* win = IN(18); bf16* wout = (bf16*)(ws + WS_SWS);
      for (int i = gt; i < 8 * 128 * 128; i += NGT) { const int s = i & 127, t = (i >> 7) & 127; wout[i] = (bf16)f2bf(s <= t ? win[i] : 0.0f); }
      float* bt = (float*)(ws + WS_BTAB); const float* rb = IN(1);
      for (int i = gt; i < 8 * 128; i += NGT) { const int h = i >> 7, d = i & 127; bt[i] = (rb[rel_bucket(d) * 8 + h] - rb[31 * 8 + h]) * LOG2E; }
    }
    for (int r0 = 4 * gw; r0 < 2 * DEPTH * NEXP; r0 += 4 * NGW) {
        const int tab = r0 / (DEPTH * NEXP), rr0 = r0 % (DEPTH * NEXP);
        const float* src = (tab == 0 ? IN(23) : IN(24)) + (size_t)rr0 * 1024 + 4 * F.lane;
        f32x4 v[4][4];
#pragma unroll
        for (int q = 0; q < 4; ++q)
#pragma unroll
            for (int i = 0; i < 4; ++i) v[q][i] = __builtin_nontemporal_load((const GAS f32x4*)(src + (size_t)q * 1024 + 256 * i));
#pragma unroll
        for (int q = 0; q < 4; ++q) quant_row_store(ws, tab, rr0 + q, v[q], F.lane);
    }
    for (int row0 = 4 * gw; row0 < T; row0 += 4 * NGW) {
        const float* src = IN(0) + (size_t)row0 * 1024 + 4 * F.lane; bf16* hb = (bf16*)(ws + WS_HBF) + (size_t)row0 * 1024 + 4 * F.lane;
        f32x4 v[4][4];
#pragma unroll
        for (int q = 0; q < 4; ++q)
#pragma unroll
            for (int i = 0; i < 4; ++i) v[q][i] = __builtin_nontemporal_load((const GAS f32x4*)(src + (size_t)q * 1024 + 256 * i));
#pragma unroll
        for (int q = 0; q < 4; ++q) { float ss = 0.f;
#pragma unroll
            for (int i = 0; i < 4; ++i) { const f32x4 x = v[q][i]; ss += (x[0] * x[0] + x[1] * x[1]) + (x[2] * x[2] + x[3] * x[3]);
                typedef unsigned u32x2 __attribute__((ext_vector_type(2))); u32x2 pw; pw.x = pk2(x[0], x[1]); pw.y = pk2(x[2], x[3]); *(GAS u32x2*)(hb + (size_t)q * 1024 + 256 * i) = pw; }
            ss = wave_sum(ss);
            if (F.lane < 16) ((float*)(ws + WS_PART))[(size_t)(row0 + q) * 16 + F.lane] = F.lane == 0 ? ss : 0.f; }
    }
}
__device__ __forceinline__ void phase_attn_combine(Frame& F, const Args& args, int j, float lam_init) {
    const int gw = F.vcu * NWAVES + F.wave, NGW = F.G * NWAVES, lane = F.lane;
    const float* lq1 = IN(7) + j * 64; const float* lk1 = IN(8) + j * 64; const float* lq2 = IN(9) + j * 64; const float* lk2 = IN(10) + j * 64;
    const float lam = expf(wave_sum(lq1[lane] * lk1[lane])) - expf(wave_sum(lq2[lane] * lk2[lane])) + lam_init;
    const int h8 = lane >> 3, e0 = (lane & 7) * 16;
    const float* sg = IN(11) + j * 128 + e0;
    f32x4 g[4];
#pragma unroll
    for (int i = 0; i < 4; ++i) g[i] = *(const GAS f32x4*)(sg + 4 * i);
    const bf16* o2 = (const bf16*)(F.ws + WS_O2); bf16* ab = (bf16*)(F.ws + WS_AB);
    for (int row = gw; row < T; row += NGW) {
        const bf16* p = o2 + (size_t)row * 2048 + h8 * 256 + e0;
        const v4u a0 = *(const GAS v4u*)p, a1 = *(const GAS v4u*)(p + 8), b0 = *(const GAS v4u*)(p + 128), b1 = *(const GAS v4u*)(p + 136);
        float o[16]; float ss = 0.f;
#pragma unroll
        for (int i = 0; i < 4; ++i) {
            o[2 * i] = bf_lo(a0[i]) - lam * bf_lo(b0[i]); o[2 * i + 1] = bf_hi(a0[i]) - lam * bf_hi(b0[i]);
            o[8 + 2 * i] = bf_lo(a1[i]) - lam * bf_lo(b1[i]); o[8 + 2 * i + 1] = bf_hi(a1[i]) - lam * bf_hi(b1[i]); }
#pragma unroll
        for (int i = 0; i < 16; ++i) ss += o[i] * o[i];
        ss += __shfl_xor(ss, 1); ss += __shfl_xor(ss, 2); ss += __shfl_xor(ss, 4);
        const float r = __builtin_amdgcn_rsqf(ss * (1.0f / 128.0f) + EPS) * (1.0f - lam_init);
        v4u w0, w1;
#pragma unroll
        for (int i = 0; i < 4; ++i) { w0[i] = pk2(o[2 * i] * r * g[i >> 1][(2 * i) & 3], o[2 * i + 1] * r * g[i >> 1][(2 * i + 1) & 3]);
                                      w1[i] = pk2(o[8 + 2 * i] * r * g[2 + (i >> 1)][(2 * i) & 3], o[8 + 2 * i + 1] * r * g[2 + (i >> 1)][(2 * i + 1) & 3]); }
        bf16* q = ab + (size_t)row * 1024 + h8 * 128 + e0; *(GAS v4u*)q = w0; *(GAS v4u*)(q + 8) = w1;
    }
}
__device__ __forceinline__ void phase_conv_mix(Frame& F, const Args& args) {
    const int gw = F.vcu * NWAVES + F.wave, NGW = F.G * NWAVES, d0 = 16 * F.lane;
    const bf16* bc = (const bf16*)(F.ws + WS_QB); const bf16* z = (const bf16*)(F.ws + WS_KB); bf16* ab = (bf16*)(F.ws + WS_AB);
    const float* cw = IN(14);
    float w0[16], w1[16], w2[16];
#pragma unroll
    for (int i = 0; i < 16; ++i) { w0[i] = cw[d0 + i]; w1[i] = cw[1024 + d0 + i]; w2[i] = cw[2048 + d0 + i]; }
    for (int row0 = 4 * gw; row0 < T; row0 += 4 * NGW) {
        const int t0 = row0 & (SEQ - 1);
        const size_t off0 = (size_t)row0 * 1024 + d0;
        v4u b[4][2], zz[6][2];
#pragma unroll
        for (int q = 0; q < 4; ++q)
#pragma unroll
            for (int hh = 0; hh < 2; ++hh) b[q][hh] = *(const GAS v4u*)(bc + off0 + (size_t)q * 1024 + 8 * hh);
#pragma unroll
        for (int q = 0; q < 6; ++q)
#pragma unroll
            for (int hh = 0; hh < 2; ++hh) zz[q][hh] = (q >= 2 || t0 >= 2) ? *(const GAS v4u*)(z + off0 + (size_t)q * 1024 - 2048 + 8 * hh) : (v4u){0u, 0u, 0u, 0u};
#pragma unroll
        for (int q = 0; q < 4; ++q) {
            v4u o[2];
#pragma unroll
            for (int hh = 0; hh < 2; ++hh)
#pragma unroll
                for (int i = 0; i < 4; ++i) { const int e = 8 * hh + 2 * i;
                    const float lo = bf_lo(b[q][hh][i]) * (w0[e] * bf_lo(zz[q][hh][i]) + w1[e] * bf_lo(zz[q + 1][hh][i]) + w2[e] * bf_lo(zz[q + 2][hh][i]));
                    const float hi = bf_hi(b[q][hh][i]) * (w0[e + 1] * bf_hi(zz[q][hh][i]) + w1[e + 1] * bf_hi(zz[q + 1][hh][i]) + w2[e + 1] * bf_hi(zz[q + 2][hh][i]));
                    o[hh][i] = pk2(lo, hi); }
            *(GAS v4u*)(ab + off0 + (size_t)q * 1024) = o[0]; *(GAS v4u*)(ab + off0 + (size_t)q * 1024 + 8) = o[1];
        }
    }
}
constexpr int SG_STRIDE = 288;
__device__ __forceinline__ void phase_sgu_spatial(Frame& F, const Args& args) {
    const int tid = F.tid, wid = F.wave, lane = F.lane, fr = lane & 15, fq = lane >> 4, wr = wid >> 2, wc = wid & 3;
    const bf16* zg = (const bf16*)(F.ws + WS_QB); const bf16* wsb = (const bf16*)(F.ws + WS_SWS); const float* part2 = (const float*)(F.ws + WS_PART2);
    bf16* ab = (bf16*)(F.ws + WS_AB); const float* vgain = IN(17); const float* bs = IN(19);
    LAS unsigned char* Wt = F.lds; LAS unsigned char* Vt = F.lds + 128 * SG_STRIDE;
    for (int unit = F.vcu; unit < 1024; unit += F.G) {
        const int g = unit & 7, chunk = unit >> 3; const int row0 = chunk * 128;
#pragma unroll
        for (int i = 0; i < 4; ++i) { const int q = tid + 512 * i, t = q >> 4, sc = q & 15;
            *(LAS v4u*)(Wt + t * SG_STRIDE + sc * 16) = *(const GAS v4u*)(wsb + ((size_t)g * 128 + t) * 128 + sc * 8); }
        { const int s = tid & 127; const float* pp = part2 + (size_t)(row0 + s) * 16;
          float sm = 0.f;
#pragma unroll
          for (int i = 0; i < 4; ++i) { const f32x4 pv = *(const GAS f32x4*)(pp + 4 * i); sm += (pv[0] + pv[1]) + (pv[2] + pv[3]); }
          const float rv = __builtin_amdgcn_rsqf(sm * (1.0f / 1024.0f) + EPS);
#pragma unroll
          for (int i = 0; i < 4; ++i) { const int cc = (tid >> 7) + 4 * i;
              const v4u x = *(const GAS v4u*)(zg + (size_t)(row0 + s) * 2048 + 1024 + g * 128 + cc * 8);
#pragma unroll
              for (int e = 0; e < 4; ++e) { *(LAS unsigned short*)(Vt + (cc * 8 + 2 * e) * SG_STRIDE + s * 2) = (unsigned short)f2bf(bf_lo(x[e]) * rv);
                                            *(LAS unsigned short*)(Vt + (cc * 8 + 2 * e + 1) * SG_STRIDE + s * 2) = (unsigned short)f2bf(bf_hi(x[e]) * rv); } } }
        LDS_WAIT(); __syncthreads();
        f32x4 acc[4][2];
#pragma unroll
        for (int m = 0; m < 4; ++m)
#pragma unroll
            for (int n = 0; n < 2; ++n) acc[m][n] = (f32x4){0.f, 0.f, 0.f, 0.f};
#pragma unroll
        for (int kk = 0; kk < 4; ++kk) {
            bf16x8 af[4], bfr[2];
#pragma unroll
            for (int m = 0; m < 4; ++m) af[m] = *(const LAS bf16x8*)(Wt + (64 * wr + 16 * m + fr) * SG_STRIDE + (32 * kk + 8 * fq) * 2);
#pragma unroll
            for (int n = 0; n < 2; ++n) bfr[n] = *(const LAS bf16x8*)(Vt + (32 * wc + 16 * n + fr) * SG_STRIDE + (32 * kk + 8 * fq) * 2);
#pragma unroll
            for (int m = 0; m < 4; ++m)
#pragma unroll
                for (int n = 0; n < 2; ++n) acc[m][n] = __builtin_amdgcn_mfma_f32_16x16x32_bf16(bfr[n], af[m], acc[m][n], 0, 0, 0);
        }
#pragma unroll
        for (int m = 0; m < 4; ++m) { const int tl = 64 * wr + 16 * m + fr; const int row = row0 + tl; const float bsv = bs[g * 128 + tl];
#pragma unroll
            for (int n = 0; n < 2; ++n) { const int c = g * 128 + 32 * wc + 16 * n + 4 * fq;
                typedef unsigned u32x2 __attribute__((ext_vector_type(2)));
                const u32x2 uu = *(const GAS u32x2*)(zg + (size_t)row * 2048 + c); const f32x4 gn = *(const GAS f32x4*)(vgain + c);
                u32x2 o; o.x = pk2(bf_lo(uu.x) * (acc[m][n][0] * gn[0] + bsv), bf_hi(uu.x) * (acc[m][n][1] * gn[1] + bsv));
                         o.y = pk2(bf_lo(uu.y) * (acc[m][n][2] * gn[2] + bsv), bf_hi(uu.y) * (acc[m][n][3] * gn[3] + bsv));
                *(GAS u32x2*)(ab + (size_t)row * 1024 + c) = o; } }
        LDS_WAIT(); __syncthreads();
    }
}
typedef float f32x2v __attribute__((ext_vector_type(2)));
template <bool F4> __device__ __forceinline__ v4u row_load(const unsigned char* tab, int e, unsigned lane) {
    if constexpr (F4) { const v2u t = *(const GAS v2u*)(tab + (size_t)(unsigned)e * 512 + 8u * lane); return (v4u){t.x, t.y, 0u, 0u}; }
    else return *(const GAS v4u*)(tab + (size_t)(unsigned)e * 1024 + 16u * lane);
}
__device__ __forceinline__ v4u row_load4(const unsigned char* tab, int& ivreg, int k, unsigned& lane8) {
    asm volatile("" : "+v"(ivreg));
    int e = __builtin_amdgcn_readlane(ivreg, k); asm volatile("" : "+s"(e));
    asm volatile("" : "+v"(lane8));
    const GAS unsigned char* rb = (const GAS unsigned char*)tab + ((size_t)(unsigned)e << 9);
    const v2u t = *(const GAS v2u*)(rb + lane8); return (v4u){t.x, t.y, 0u, 0u};
}
template <bool F4, int P> __device__ __forceinline__ f32x2v row_pair(const v4u& w) {
    if constexpr (F4) return __builtin_amdgcn_cvt_scalef32_pk_f32_fp4(w[P >> 2], 1.0f, P & 3);
    else return __builtin_amdgcn_cvt_pk_f32_fp8((int)w[P >> 1], (P & 1) != 0);
}
#define P8(X) X(0) X(1) X(2) X(3) X(4) X(5) X(6) X(7)
__device__ __forceinline__ float dpp_xor1(float v) { return __builtin_bit_cast(float, __builtin_amdgcn_update_dpp(0, __builtin_bit_cast(int, v), 0xB1, 0xF, 0xF, true)); }
__device__ __forceinline__ float dpp_xor2(float v) { return __builtin_bit_cast(float, __builtin_amdgcn_update_dpp(0, __builtin_bit_cast(int, v), 0x4E, 0xF, 0xF, true)); }
__device__ __forceinline__ float swz_xor4(float v) { return __builtin_bit_cast(float, __builtin_amdgcn_ds_swizzle(__builtin_bit_cast(int, v), 0x101F)); }
__device__ __forceinline__ float dpp_xor8(float v) { return __builtin_bit_cast(float, __builtin_amdgcn_update_dpp(0, __builtin_bit_cast(int, v), 0x128, 0xF, 0xF, true)); }
__device__ __forceinline__ float reduce16(const float (&pr)[16], int lane) {
    const bool b0 = (lane & 1) != 0, b1 = (lane & 2) != 0, b2 = (lane & 4) != 0, b3 = (lane & 8) != 0;
    float a[8], b[4], c[2];
#pragma unroll
    for (int i = 0; i < 8; ++i) { const float keep = b0 ? pr[2 * i + 1] : pr[2 * i], send = b0 ? pr[2 * i] : pr[2 * i + 1]; a[i] = keep + dpp_xor1(send); }
#pragma unroll
    for (int i = 0; i < 4; ++i) { const float keep = b1 ? a[2 * i + 1] : a[2 * i], send = b1 ? a[2 * i] : a[2 * i + 1]; b[i] = keep + dpp_xor2(send); }
#pragma unroll
    for (int i = 0; i < 2; ++i) { const float keep = b2 ? b[2 * i + 1] : b[2 * i], send = b2 ? b[2 * i] : b[2 * i + 1]; c[i] = keep + swz_xor4(send); }
    float v; { const float keep = b3 ? c[1] : c[0], send = b3 ? c[0] : c[1]; v = keep + dpp_xor8(send); }
    v += __shfl_xor(v, 16); v += __shfl_xor(v, 32);
    return v;
}
template <bool LAST>
__device__ __forceinline__ void phase_peer_expert(Frame& F, const Args& args, int layer, float psc) {
    const int gw = F.vcu * NWAVES + F.wave, NGW = F.G * NWAVES, lane = F.lane;
    const unsigned char* U8 = F.ws + WS_U8 + (size_t)layer * NEXP * URB; const unsigned char* V8 = F.ws + WS_V8 + (size_t)layer * NEXP * VRB;
    LAS float* su = (LAS float*)(F.lds); LAS float* sv = (LAS float*)(F.lds + NEXP * 4);
    {   const float* gsu = (const float*)(F.ws + WS_SU) + layer * NEXP; const float* gsv = (const float*)(F.ws + WS_SV) + layer * NEXP;
#pragma unroll
        for (int i = 0; i < NEXP / (512 * 4); ++i) { const int o = (i * 512 + F.tid) * 4;
            *(LAS f32x4*)(su + o) = *(const GAS f32x4*)(gsu + o); *(LAS f32x4*)(sv + o) = *(const GAS f32x4*)(gsv + o); }
        LDS_WAIT(); __syncthreads(); }
    const float* part = (const float*)(F.ws + WS_PART); float* partw = (float*)(F.ws + WS_PART);
    const int* idxp = (const int*)(F.ws + WS_IDX); const float* gatep = (const float*)(F.ws + WS_GATE);
    const float* gf = IN(3) + layer * 1024 + 4 * lane;
    constexpr bool conv_next = false;
    const float* cu_src = IN(23) + (size_t)(conv_next ? layer + 1 : layer) * NEXP * 1024 + 4 * lane; const float* cv_src = IN(24) + (size_t)(conv_next ? layer + 1 : layer) * NEXP * 1024 + 4 * lane;
    f32x4 gn[4];
#pragma unroll
    for (int i = 0; i < 4; ++i) gn[i] = *(const GAS f32x4*)(gf + 256 * i);
    constexpr int RD = 16;
    static_assert(UF4 && VF4, "row_load4 gathers fp4 rows");
    unsigned lane8 = 8u * (unsigned)lane;
#define ROWLD_S(s_) (((s_) < 128) ? row_load4(U8, iv[((s_) >> 6) & 1], (s_) & 63, lane8) : \
                     ((s_) < 256) ? row_load4(V8, iv[((s_) >> 6) & 1], (s_) & 63, lane8) : \
                                    row_load4(U8, iv_n[0], (s_) & 63, lane8))
#define PIN_VMEM() __builtin_amdgcn_sched_barrier(0x1 | 0x2 | 0x4 | 0x80 | 0x100 | 0x200)
    int t = gw;
    if (t >= T) return;
    typedef unsigned u32x2 __attribute__((ext_vector_type(2)));
    const bf16* hbase = (const bf16*)(F.ws + WS_HBF) + 4 * lane;
    int iv[2]; float gt[2]; u32x2 hv[4]; f32x4 pv;
#pragma unroll
    for (int hh = 0; hh < 2; ++hh) { iv[hh] = idxp[(size_t)t * 128 + 64 * hh + lane]; gt[hh] = gatep[(size_t)t * 128 + 64 * hh + lane]; }
#pragma unroll
    for (int i = 0; i < 4; ++i) hv[i] = *(const GAS u32x2*)(hbase + (size_t)t * 1024 + 256 * i);
    pv = *(const GAS f32x4*)(part + (size_t)t * 16 + 4 * (lane & 3));
    v4u buf[RD];
    { int iv_n[2] = {iv[0], iv[1]}; (void)iv_n;
#pragma unroll
      for (int j = 0; j < RD; ++j) buf[j] = ROWLD_S(j);
      PIN_VMEM(); }
    for (;;) {
        const int tn = t + NGW; const bool has_next = tn < T; const int tq = has_next ? tn : t;
        float* hrow = F.out + (size_t)t * 1024 + 4 * lane;
        int iv_n[2]; float gt_n[2]; u32x2 hv_n[4]; f32x4 pv_n;
#pragma unroll
        for (int hh = 0; hh < 2; ++hh) { iv_n[hh] = idxp[(size_t)tq * 128 + 64 * hh + lane]; gt_n[hh] = gatep[(size_t)tq * 128 + 64 * hh + lane]; }
#pragma unroll
        for (int i = 0; i < 4; ++i) hv_n[i] = *(const GAS u32x2*)(hbase + (size_t)tq * 1024 + 256 * i);
        pv_n = *(const GAS f32x4*)(part + (size_t)tq * 16 + 4 * (lane & 3));
        f32x4 cu[4], cv[4];
        if (conv_next) {
#pragma unroll
            for (int i = 0; i < 4; ++i) { cu[i] = __builtin_nontemporal_load((const GAS f32x4*)(cu_src + (size_t)t * 1024 + 256 * i)); cv[i] = __builtin_nontemporal_load((const GAS f32x4*)(cv_src + (size_t)t * 1024 + 256 * i)); }
        }
        float s_u[2], s_v[2];
#pragma unroll
        for (int hh = 0; hh < 2; ++hh) { s_u[hh] = su[iv[hh]]; s_v[hh] = sv[iv[hh]]; }
        PIN_VMEM();
        float rs; { float s = (pv[0] + pv[1]) + (pv[2] + pv[3]); s += __shfl_xor(s, 1); s += __shfl_xor(s, 2); rs = __builtin_amdgcn_rsqf(s * (1.0f / 1024.0f) + EPS); }
        f32x2v x2[8];
#pragma unroll
        for (int i = 0; i < 4; ++i) { x2[2 * i] = (f32x2v){bf_lo(hv[i].x) * rs * gn[i][0], bf_hi(hv[i].x) * rs * gn[i][1]}; x2[2 * i + 1] = (f32x2v){bf_lo(hv[i].y) * rs * gn[i][2], bf_hi(hv[i].y) * rs * gn[i][3]}; }
        float coef[2];
#pragma unroll
        for (int hh = 0; hh < 2; ++hh) {
            float actv = 0.f;
#pragma unroll
            for (int kb = 0; kb < 4; ++kb) {
                float pr[16];
#pragma unroll
                for (int kj = 0; kj < 16; ++kj) {
                    const int k = 16 * kb + kj, s = 64 * hh + k; const v4u w = buf[s % RD];
                    buf[s % RD] = ROWLD_S(s + RD);
                    PIN_VMEM();
                    f32x2v d2 = {0.f, 0.f};
#define DOTP(p) d2 += row_pair<UF4, p>(w) * x2[p];
                    P8(DOTP)
#undef DOTP
                    pr[kj] = d2.x + d2.y;
                }
                const float v = reduce16(pr, lane);
                actv = ((lane >> 4) == kb) ? v : actv;
            }
            coef[hh] = gelu_tanh_f(actv * s_u[hh]) * gt[hh] * s_v[hh] * psc;
        }
        f32x2v o2[8];
#pragma unroll
        for (int i = 0; i < 8; ++i) o2[i] = (f32x2v){0.f, 0.f};
#pragma unroll
        for (int hh = 0; hh < 2; ++hh) {
#pragma unroll
            for (int k = 0; k < 64; ++k) {
                const int s = 128 + 64 * hh + k; const v4u w = buf[s % RD];
                buf[s % RD] = ROWLD_S(s + RD);
                PIN_VMEM();
                const float c = __builtin_bit_cast(float, __builtin_amdgcn_readlane(__builtin_bit_cast(int, coef[hh]), k));
                const f32x2v c2 = {c, c};
#define ACCP(p) o2[p] += c2 * row_pair<VF4, p>(w);
                P8(ACCP)
#undef ACCP
            }
        }
        float ss = 0.f;
        bf16* hb = (bf16*)(F.ws + WS_HBF) + (size_t)t * 1024 + 4 * lane;
#pragma unroll
        for (int i = 0; i < 4; ++i) {
            const f32x4 nv = {bf_lo(hv[i].x) + o2[2 * i].x, bf_hi(hv[i].x) + o2[2 * i].y, bf_lo(hv[i].y) + o2[2 * i + 1].x, bf_hi(hv[i].y) + o2[2 * i + 1].y};
            ss += (nv[0] * nv[0] + nv[1] * nv[1]) + (nv[2] * nv[2] + nv[3] * nv[3]);
            if (LAST) *(GAS f32x4*)(hrow + 256 * i) = nv;
            else { asm volatile("global_store_dwordx2 %0, %1, off sc0 sc1\n\ts_nop 1" :: "v"(hb + 256 * i), "v"((u32x2){pk2(nv[0], nv[1]), pk2(nv[2], nv[3])}) : "memory"); } }
        ss = wave_sum(ss);
        if (lane < 16) partw[(size_t)t * 16 + lane] = lane == 0 ? ss : 0.f;
        if (conv_next) { quant_row_store(F.ws, 0, (layer + 1) * NEXP + t, cu, lane); quant_row_store(F.ws, 1, (layer + 1) * NEXP + t, cv, lane); }
        if (!has_next) break;
        t = tn;
#pragma unroll
        for (int hh = 0; hh < 2; ++hh) { iv[hh] = iv_n[hh]; gt[hh] = gt_n[hh]; }
#pragma unroll
        for (int i = 0; i < 4; ++i) hv[i] = hv_n[i];
        pv = pv_n;
    }
#undef ROWLD_S
#undef PIN_VMEM
}
#ifndef EN_P0
#define EN_P0 1
#endif
#ifndef EN_QKV
#define EN_QKV 1
#endif
#ifndef EN_ATTN
#define EN_ATTN 1
#endif
#ifndef EN_COMB
#define EN_COMB 1
#endif
#ifndef EN_OUT
#define EN_OUT 1
#endif
#ifndef EN_CIN
#define EN_CIN 1
#endif
#ifndef EN_CONV2
#define EN_CONV2 1
#endif
#ifndef EN_SIN
#define EN_SIN 1
#endif
#ifndef EN_SGU2
#define EN_SGU2 1
#endif
#ifndef EN_ROUTE
#define EN_ROUTE 1
#endif
#ifndef EN_EXP
#define EN_EXP 1
#endif
constexpr int N_PHASES = 1 + 6 * DEPTH;
__global__ void __launch_bounds__(NWAVES * 64, 2) mega_fwd(Args args) {
    extern __shared__ __attribute__((aligned(16))) unsigned char lds[];
    Frame F;
    F.lds = (LAS unsigned char*)lds; F.MISC = (volatile LAS unsigned*)(F.lds + MISC_OFF);
    F.tid = threadIdx.x; F.lane = F.tid & 63; F.wave = __builtin_amdgcn_readfirstlane(F.tid >> 6);
    F.G = gridDim.x; { const int bx = blockIdx.x; F.vcu = (F.G % 8 == 0) ? (bx % 8) * (F.G / 8) + bx / 8 : bx; }
    F.ws = args.ws; F.ctl = (gu32*)(args.ws + WS_CTL); F.out = args.out;
    if (F.tid < 128) ((LAS unsigned*)(F.lds + MISC_OFF))[F.tid] = 0u;
    __syncthreads();
    XcdBarrier bar = xcd_barrier_post((unsigned*)(F.ctl + CW_BAR) + args.li * XCD_BAR_WORDS, F.MISC + 8);
    bool first = true;
#ifndef PROBE_CLASS
#define PROBE_CLASS 0
#endif
#define PHASE_BEGIN(p, cls) if (args.ph_lo <= (p) && (p) < args.ph_hi) for (int rep_ = ((cls) == PROBE_CLASS ? 0 : 1); rep_ < 2; ++rep_) { if (!first) xcd_barrier(bar); first = false; \
    const float psc = rep_ ? 1.0f : (float)args.pad; (void)psc; \
    int t_ = threadIdx.x; asm volatile("" : "+v"(t_)); F.tid = t_; F.lane = t_ & 63; F.wave = __builtin_amdgcn_readfirstlane(t_ >> 6); \
    size_t z_ = 0; asm volatile("" : "+s"(z_)); unsigned char* ws = args.ws + z_; float* out_ = args.out + z_; F.ws = ws; F.out = out_; F.ctl = (gu32*)args.ws;
#define PHASE_END }
    PHASE_BEGIN(0, 1)
#if EN_P0
        p0_prologue(F, args);
#endif
    PHASE_END
#pragma unroll 1
    for (int layer = 0; layer < DEPTH; ++layer) {
        const int pb = 1 + 6 * layer, mix = layer % 3, j = layer / 3;
        if (mix == 0) {
            PHASE_BEGIN(pb + 0, 2)
#if EN_QKV
            {   pg8::Gemm g{(const pg8::bf16_t*)(ws + WS_HBF), (const pg8::bf16_t*)(ws + WS_WQKV) + (size_t)j * 3072 * 1024};
                pg8::StaticOrderT<3072> S; S.init(F.G, (int)blockIdx.x);
                pg8::EpiQKV E{ws, IN(5) + j * 64, IN(6) + j * 64};
                pg8::gemm_phase<pg8::EpiQKV, pg8::StaticOrderT<3072>, true, true>(F.lds + RING_OFF, g, S, E); }
#endif
            PHASE_END
            PHASE_BEGIN(pb + 1, 3)
#if EN_ATTN
            {   const attn_body::AttnTensors AT{(const attn_body::bf16*)(ws + WS_QB), (const attn_body::bf16*)(ws + WS_KB), (const attn_body::bf16*)(ws + WS_VB), (attn_body::bf16*)(ws + WS_O2)};
                const float lam_init = 0.8f - 0.6f * expf(-0.3f * (float)layer);
                const float* lq1 = IN(7) + j * 64; const float* lk1 = IN(8) + j * 64; const float* lq2 = IN(9) + j * 64; const float* lk2 = IN(10) + j * 64;
                const float lam = expf(wave_sum(lq1[F.lane] * lk1[F.lane])) - expf(wave_sum(lq2[F.lane] * lk2[F.lane])) + lam_init;
                const attn_body::AttnCombine AC{__builtin_bit_cast(float, __builtin_amdgcn_readfirstlane(__builtin_bit_cast(int, lam))), __builtin_bit_cast(float, __builtin_amdgcn_readfirstlane(__builtin_bit_cast(int, lam_init))), IN(11) + j * 128, (attn_body::bf16*)(ws + WS_AB)};
                attn_body::attn_phase<8>((char*)lds + RING_OFF, AT, F.vcu, F.G, (const float*)(ws + WS_BTAB), AC); }
#endif
            PHASE_END
        } else if (mix == 1) {
            PHASE_BEGIN(pb + 0, 2)
#if EN_CIN
            {   pg8::Gemm g{(const pg8::bf16_t*)(ws + WS_HBF), (const pg8::bf16_t*)(ws + WS_CIN)};
                pg8::StaticOrderT<3072> S; S.init(F.G, (int)blockIdx.x);
                pg8::EpiConvIn E{ws};
                pg8::gemm_phase<pg8::EpiConvIn, pg8::StaticOrderT<3072>, true, true>(F.lds + RING_OFF, g, S, E); }
#endif
            PHASE_END
            PHASE_BEGIN(pb + 1, 7)
#if EN_CONV2
                phase_conv_mix(F, args);
#endif
            PHASE_END
        } else {
            PHASE_BEGIN(pb + 0, 2)
#if EN_SIN
            {   pg8::Gemm g{(const pg8::bf16_t*)(ws + WS_HBF), (const pg8::bf16_t*)(ws + WS_SIN)};
                pg8::StaticOrderT<2048> S; S.init(F.G, (int)blockIdx.x);
                pg8::EpiSguIn E{ws};
                pg8::gemm_phase<pg8::EpiSguIn, pg8::StaticOrderT<2048>, true, true>(F.lds + RING_OFF, g, S, E); }
#endif
            PHASE_END
            PHASE_BEGIN(pb + 1, 7)
#if EN_SGU2
                phase_sgu_spatial(F, args);
#endif
            PHASE_END
        }
        PHASE_BEGIN(pb + 3, 4)
#if EN_OUT
        {   const size_t woff = mix == 0 ? WS_WO + (size_t)j * 1024 * 1024 * 2 : (mix == 1 ? WS_COUT : WS_SOUT);
            pg8::Gemm g{(const pg8::bf16_t*)(ws + WS_AB), (const pg8::bf16_t*)(ws + woff)};
            pg8::StaticOrderT<1024> S; S.init(F.G, (int)blockIdx.x);
            pg8::EpiResid E{ws, psc};
            pg8::gemm_phase<pg8::EpiResid, pg8::StaticOrderT<1024>, true, true>(F.lds + RING_OFF, g, S, E); }
#endif
        PHASE_END
        PHASE_BEGIN(pb + 4, 5)
#if EN_ROUTE
        {   pg8::Gemm g{(const pg8::bf16_t*)(ws + WS_HBF), (const pg8::bf16_t*)(ws + WS_PWQ) + (size_t)layer * 2048 * 1024};
            pg8::EpiRoute E{ws, layer, 0, pg8::Unit{}};
            pg8::OneUnit S; S.S.init(F.G, (int)blockIdx.x);
            pg8::Unit uu;
#pragma unroll 1
            for (int k = 0; S.S.next(k, uu); ++k) { S.k = k; pg8::Unit nx; E.mode = (k & 1) ? 2 : (S.S.next(k + 1, nx) ? 1 : 0);
                pg8::gemm_phase<pg8::EpiRoute, pg8::OneUnit, false, true>(F.lds + RING_OFF, g, S, E); E.prev = uu; } }
#endif
        PHASE_END
        PHASE_BEGIN(pb + 5, 6)
#if EN_EXP
            if (layer == DEPTH - 1) phase_peer_expert<true>(F, args, layer, psc); else phase_peer_expert<false>(F, args, layer, psc);
#endif
        PHASE_END
    }
#undef PHASE_BEGIN
#undef PHASE_END
}
extern "C" void kernel_launch(void* const* d_in, const int* in_sizes, int n_in, void* d_out, int out_size, void* d_ws, size_t ws_size, hipStream_t stream) {
    static int grid = 0;
    if (grid == 0) {
        if (n_in != 25 || out_size != T * D || ws_size < WS_END) { fprintf(stderr, "kernel_launch: unexpected problem shape (n_in %d, out %d, ws %zu)\n", n_in, out_size, ws_size); grid = -1; return; }
        int dev = 0, cus = 0, per_cu = 0;
        if (hipGetDevice(&dev) != hipSuccess || hipDeviceGetAttribute(&cus, hipDeviceAttributeMultiprocessorCount, dev) != hipSuccess) { grid = -1; return; }
        if (hipFuncSetAttribute((const void*)mega_fwd, hipFuncAttributeMaxDynamicSharedMemorySize, LDS_BYTES) != hipSuccess) { fprintf(stderr, "kernel_launch: hipFuncSetAttribute failed\n"); grid = -1; return; }
        if (hipOccupancyMaxActiveBlocksPerMultiprocessor(&per_cu, (const void*)mega_fwd, NWAVES * 64, LDS_BYTES) != hipSuccess || per_cu < 1) fprintf(stderr, "kernel_launch: occupancy query says %d\n", per_cu);
        (void)hipGetLastError();
        grid = cus;
    }
    if (grid < 0) return;
    (void)hipMemsetAsync((char*)d_ws + WS_CTL, 0, CTL_ZERO_BYTES, stream);
    Args a{};
    for (int i = 0; i < 25; ++i) a.in[i] = (const float*)d_in[i];
    a.out = (float*)d_out; a.ws = (unsigned char*)d_ws;
    a.ph_lo = 0; a.ph_hi = N_PHASES; a.li = 0; a.pad = 0;
    hipLaunchKernelGGL(mega_fwd, dim3(grid), dim3(NWAVES * 64), LDS_BYTES, stream, a);
}
```

```cpp
#include <hip/hip_runtime.h>
#include <hip/hip_bf16.h>
#include <cstdio>
#include <cstdint>
#include <cmath>
constexpr int NWAVES = 8;
constexpr int T = 16384, D = 1024, SEQ = 2048, BATCH = 8, DEPTH = 4, NEXP = 16384;
constexpr float EPS = 1e-6f, LOG2E = 1.4426950408889634f;
constexpr size_t MiB = 1u << 20;
constexpr size_t WS_CTL = 0, CTL_ZERO_BYTES = 1 * MiB;
constexpr size_t WS_WQKV = 2 * MiB;
constexpr size_t WS_WO = 14 * MiB;
constexpr size_t WS_CIN = 18 * MiB;
constexpr size_t WS_COUT = 24 * MiB;
constexpr size_t WS_SIN = 26 * MiB;
constexpr size_t WS_SOUT = 30 * MiB;
constexpr size_t WS_SWS = 32 * MiB;
constexpr size_t WS_PWQ = 34 * MiB;
constexpr size_t WS_PKEY = 50 * MiB;
constexpr size_t WS_BTAB = 52 * MiB;
constexpr size_t WS_PART = 54 * MiB;
constexpr size_t WS_PART2 = 55 * MiB;
constexpr size_t WS_SU = 56 * MiB;
constexpr size_t WS_SV = 57 * MiB;
constexpr size_t WS_U8 = 64 * MiB;
constexpr size_t WS_STASH = 96 * MiB;
constexpr size_t WS_V8 = 128 * MiB;
constexpr size_t WS_HBF = 200 * MiB;
constexpr size_t WS_QB = 232 * MiB, WS_KB = 264 * MiB, WS_VB = 296 * MiB;
constexpr size_t WS_O2 = 328 * MiB;
constexpr size_t WS_AB = 392 * MiB;
constexpr size_t WS_IDX = 424 * MiB, WS_GATE = 432 * MiB;
constexpr size_t WS_END = 440 * MiB;
constexpr int CW_TMO = 0, CW_BAR = 4096;
constexpr int RING_OFF = 0, RING_BYTES = 131072;
constexpr int LDS_BYTES = 163840;
constexpr int MISC_OFF = LDS_BYTES - 512;
#ifndef U_FP4
#define U_FP4 1
#endif
#ifndef V_FP4
#define V_FP4 1
#endif
constexpr bool UF4 = U_FP4 != 0, VF4 = V_FP4 != 0;
constexpr int URB = UF4 ? 512 : 1024, VRB = VF4 ? 512 : 1024;
typedef unsigned v2u __attribute__((ext_vector_type(2)));
namespace pg8 {
#define PG8_LAS __attribute__((address_space(3)))
typedef unsigned short bf16_t;
typedef short bf16x8 __attribute__((ext_vector_type(8)));
typedef float f32x4 __attribute__((ext_vector_type(4)));
typedef unsigned u32x4 __attribute__((ext_vector_type(4)));
constexpr int BM = 256, BK = 64, HALF = 128, HTB = HALF * BK * 2  , STAGE_BYTES = 8 * HTB, NXCD = 8, WGM = 8;

__host__ __device__ __forceinline__ int lds_byte(int r, int c) { const int st = (r >> 4) * 2 + (c >> 5), rr = r & 15, cc = c & 31, ob = rr * 64 + cc * 2; return st * 1024 + (ob ^ (((ob >> 9) & 1) << 5)); }
__host__ __device__ __forceinline__ void stage_rc(int b, int& R, int& C) { const int st = b / 1024, sb = b % 1024, swz = sb ^ (((sb >> 9) & 1) << 5); R = (st >> 1) * 16 + swz / 64; C = (st & 1) * 32 + (swz % 64) / 2; }
__host__ __device__ __forceinline__ int perm32(int rho) { const int n = rho >> 4, i = rho & 15; return 8 * (i >> 2) + 4 * n + (i & 3); }

struct Unit { int pm, pn; };
struct Gemm { const bf16_t* A; const bf16_t* Bt; };

template <int NN> struct StaticOrderT {
    static constexpr int nM = 16384 / BM, nN = NN / BM, nwg = nM * nN;
    int G, c;
    __host__ __device__ void init(int G_, int c_) { G = G_; c = c_; }
    __host__ __device__ bool next(int i, Unit& u) const {
        const long L = (long)i * G + c; if (L >= nwg) return false;
        int wgid = (int)L; { constexpr int q = nwg / NXCD, r = nwg % NXCD; const int xcd = wgid % NXCD, off = wgid / NXCD; wgid = (xcd < r ? xcd * (q + 1) : r * (q + 1) + (xcd - r) * q) + off; }
        constexpr int nig = WGM * nN; const int gid = wgid / nig, fm = gid * WGM, gsz = (nM - fm) < WGM ? (nM - fm) : WGM;
        u.pm = fm + ((wgid % nig) % gsz); u.pn = (wgid % nig) / gsz; return true;
    }
    __device__ __forceinline__ void a_ready(const Unit&) const {}
    __device__ __forceinline__ void done(const Unit&) const {}
};

__device__ __forceinline__ unsigned cvt_pk_bf16(float lo, float hi) { unsigned r; asm volatile("v_cvt_pk_bf16_f32 %0, %1, %2" : "=v"(r) : "v"(lo), "v"(hi)); return r; }
typedef float f32x2 __attribute__((ext_vector_type(2)));
constexpr float K_EPS = 1e-6f;
__device__ __forceinline__ void st16_wt(void* p, u32x4 v) { asm volatile("global_store_dwordx4 %0, %1, off sc0 sc1\n\ts_nop 1" :: "v"(p), "v"(v) : "memory"); }
__device__ __forceinline__ void st8_wt(void* p, unsigned lo, unsigned hi) { typedef unsigned u32x2w __attribute__((ext_vector_type(2))); const u32x2w v = {lo, hi}; asm volatile("global_store_dwordx2 %0, %1, off sc0 sc1\n\ts_nop 1" :: "v"(p), "v"(v) : "memory"); }
constexpr float K_LOG2E = 1.4426950408889634f;
__device__ __forceinline__ unsigned pk_bf16(float lo, float hi) { f32x2 v = {lo, hi}; typedef __bf16 bf16x2_t __attribute__((ext_vector_type(2))); bf16x2_t b = __builtin_convertvector(v, bf16x2_t); return __builtin_bit_cast(unsigned, b); }
__device__ __forceinline__ float gelu_t(float x) {
    const float y = 0.7978845608028654f * (x + 0.044715f * x * x * x);
    return x * __builtin_amdgcn_rcpf(1.0f + __builtin_amdgcn_exp2f(-2.0f * K_LOG2E * y));
}
__device__ __forceinline__ float row_rstd(const float* part, int row, int fq) {
    const f32x4 v = *(const f32x4*)(part + (size_t)row * 16 + 4 * fq);
    float s = (v[0] + v[1]) + (v[2] + v[3]);
    s += __shfl_xor(s, 16); s += __shfl_xor(s, 32);
    return __builtin_amdgcn_rsqf(s * (1.0f / 1024.0f) + K_EPS);
}
struct EpiResid {
    static constexpr bool PERM = false, AFTER_DRAIN = false;
    unsigned char* ws; float sc;
    __device__ __forceinline__ void operator()(const f32x4 (&acc)[2][2][4][2], const Unit& u, int wr, int wc, int fr, int fq) const {
        const int col0 = u.pn * BM + wc * 32 + 4 * fq; bf16_t* hbf = (bf16_t*)(ws + WS_HBF); float* part = (float*)(ws + WS_PART);
        typedef unsigned u32x2 __attribute__((ext_vector_type(2)));
#pragma unroll
        for (int ai = 0; ai < 2; ++ai)
#pragma unroll
            for (int m = 0; m < 4; ++m) {
                const int row = u.pm * BM + ai * HALF + wr * 64 + m * 16 + fr; const size_t off = (size_t)row * 1024 + col0; float ss = 0.f;
#pragma unroll
                for (int bj = 0; bj < 2; ++bj)
#pragma unroll
                    for (int n = 0; n < 2; ++n) {
                        u32x2* q = (u32x2*)(hbf + off + bj * HALF + n * 16); const u32x2 o = *q; const f32x4 a = acc[ai][bj][m][n] * sc;
                        const f32x4 v = {__uint_as_float(o.x << 16) + a[0], __uint_as_float(o.x & 0xffff0000u) + a[1], __uint_as_float(o.y << 16) + a[2], __uint_as_float(o.y & 0xffff0000u) + a[3]};
                        ss += (v[0] * v[0] + v[1] * v[1]) + (v[2] * v[2] + v[3] * v[3]);
                        u32x2 w; w.x = pk_bf16(v[0], v[1]); w.y = pk_bf16(v[2], v[3]); *q = w; }
                ss += __shfl_xor(ss, 16); ss += __shfl_xor(ss, 32);
                if (fq == 0) part[(size_t)row * 16 + u.pn * 4 + wc] = ss;
                if (m & 1) asm volatile("" ::: "memory");
            }
    }
};
struct EpiQKV {
    static constexpr bool PERM = true, AFTER_DRAIN = false;
    unsigned char* ws; const float* qg; const float* kg;
    __device__ __forceinline__ void operator()(const f32x4 (&acc)[2][2][4][2], const Unit& u, int wr, int wc, int fr, int fq) const {
        const int sec = u.pn >> 2; bf16_t* dst = (bf16_t*)(ws + WS_QB + (size_t)sec * (WS_KB - WS_QB)); const float* part = (const float*)(ws + WS_PART); constexpr float c2 = 0.125f * K_LOG2E;
        const int colb = (u.pn & 3) * BM + 64 * wc + 8 * fq;
        f32x4 g[2][2];
#pragma unroll
        for (int bj = 0; bj < 2; ++bj)
#pragma unroll
            for (int n = 0; n < 2; ++n) { g[bj][n] = (f32x4){1.f, 1.f, 1.f, 1.f};
                if (sec < 2) { const f32x4 t = *(const f32x4*)((sec == 0 ? qg : kg) + 32 * bj + 8 * fq + 4 * n); g[bj][n] = sec == 0 ? t * c2 : t; } }
#pragma unroll
        for (int ai = 0; ai < 2; ++ai)
#pragma unroll
            for (int m = 0; m < 4; ++m) {
                const int row = u.pm * BM + ai * HALF + wr * 64 + m * 16 + fr; const float rs = row_rstd(part, row, fq);
                f32x4 v[2][2]; float ss = 0.f;
#pragma unroll
                for (int bj = 0; bj < 2; ++bj)
#pragma unroll
                    for (int n = 0; n < 2; ++n) { v[bj][n] = acc[ai][bj][m][n] * rs; ss += (v[bj][n][0] * v[bj][n][0] + v[bj][n][1] * v[bj][n][1]) + (v[bj][n][2] * v[bj][n][2] + v[bj][n][3] * v[bj][n][3]); }
                float rn = 1.f;
                if (sec < 2) { ss += __shfl_xor(ss, 16); ss += __shfl_xor(ss, 32); rn = __builtin_amdgcn_rsqf(ss * (1.0f / 64.0f) + K_EPS); }
#pragma unroll
                for (int bj = 0; bj < 2; ++bj) { const f32x4 a = v[bj][0] * rn * g[bj][0], b = v[bj][1] * rn * g[bj][1];
                    u32x4 w; w.x = pk_bf16(a[0], a[1]); w.y = pk_bf16(a[2], a[3]); w.z = pk_bf16(b[0], b[1]); w.w = pk_bf16(b[2], b[3]);
                    st16_wt(dst + (size_t)row * 1024 + colb + 32 * bj, w); }
            }
    }
};
struct EpiConvIn {
    static constexpr bool PERM = true, AFTER_DRAIN = false;
    unsigned char* ws;
    __device__ __forceinline__ void operator()(const f32x4 (&acc)[2][2][4][2], const Unit& u, int wr, int wc, int fr, int fq) const {
        const float* part = (const float*)(ws + WS_PART); bf16_t* bc = (bf16_t*)(ws + WS_QB); bf16_t* z = (bf16_t*)(ws + WS_KB);
#pragma unroll
        for (int ai = 0; ai < 2; ++ai)
#pragma unroll
            for (int m = 0; m < 4; ++m) {
                const int row = u.pm * BM + ai * HALF + wr * 64 + m * 16 + fr; const float rs = row_rstd(part, row, fq);
                if (u.pn < 4) {
#pragma unroll
                    for (int bj = 0; bj < 2; ++bj) { const f32x4 a = acc[ai][bj][m][0] * rs, b = acc[ai][bj][m][1] * rs;
                        u32x4 w; w.x = pk_bf16(a[0], a[1]); w.y = pk_bf16(a[2], a[3]); w.z = pk_bf16(b[0], b[1]); w.w = pk_bf16(b[2], b[3]);
                        st16_wt(bc + (size_t)row * 1024 + u.pn * BM + bj * HALF + wc * 32 + 8 * fq, w); }
                } else { const float r2 = rs * rs;
                    const f32x4 a = acc[ai][0][m][0] * acc[ai][1][m][0] * r2, b = acc[ai][0][m][1] * acc[ai][1][m][1] * r2;
                    u32x4 w; w.x = pk_bf16(a[0], a[1]); w.y = pk_bf16(a[2], a[3]); w.z = pk_bf16(b[0], b[1]); w.w = pk_bf16(b[2], b[3]);
                    st16_wt(z + (size_t)row * 1024 + (u.pn - 4) * HALF + wc * 32 + 8 * fq, w); }
            }
    }
};
struct EpiSguIn {
    static constexpr bool PERM = true, AFTER_DRAIN = false;
    unsigned char* ws;
    __device__ __forceinline__ void operator()(const f32x4 (&acc)[2][2][4][2], const Unit& u, int wr, int wc, int fr, int fq) const {
        const float* part = (const float*)(ws + WS_PART); bf16_t* zg = (bf16_t*)(ws + WS_QB); float* part2 = (float*)(ws + WS_PART2);
#pragma unroll
        for (int ai = 0; ai < 2; ++ai)
#pragma unroll
            for (int m = 0; m < 4; ++m) {
                const int row = u.pm * BM + ai * HALF + wr * 64 + m * 16 + fr; const float rs = row_rstd(part, row, fq); float ss = 0.f;
#pragma unroll
                for (int bj = 0; bj < 2; ++bj) { f32x4 a = acc[ai][bj][m][0] * rs, b = acc[ai][bj][m][1] * rs;
#pragma unroll
                    for (int j = 0; j < 4; ++j) { a[j] = gelu_t(a[j]); b[j] = gelu_t(b[j]); ss += a[j] * a[j] + b[j] * b[j]; }
                    u32x4 w; w.x = pk_bf16(a[0], a[1]); w.y = pk_bf16(a[2], a[3]); w.z = pk_bf16(b[0], b[1]); w.w = pk_bf16(b[2], b[3]);
                    st16_wt(zg + (size_t)row * 2048 + u.pn * BM + bj * HALF + wc * 32 + 8 * fq, w); }
                if (u.pn >= 4) { ss += __shfl_xor(ss, 16); ss += __shfl_xor(ss, 32); if (fq == 0) part2[(size_t)row * 16 + (u.pn - 4) * 4 + wc] = ss; }
            }
    }
};
__device__ __forceinline__ void ce_desc(float& a, float& b) { const float hi = __builtin_fmaxf(a, b), lo = __builtin_fminf(a, b); a = hi; b = lo; }
template <int N> __device__ __forceinline__ void bitonic_sort_desc(float (&v)[N]) {
#pragma unroll
    for (int k = 2; k <= N; k <<= 1)
#pragma unroll
        for (int j = k >> 1; j > 0; j >>= 1)
#pragma unroll
            for (int i = 0; i < N; ++i) { const int l = i ^ j; if (l > i) { if ((i & k) == 0) ce_desc(v[i], v[l]); else ce_desc(v[l], v[i]); } }
}
__device__ __forceinline__ void bitonic_merge_desc16(float (&v)[16]) {
#pragma unroll
    for (int j = 8; j > 0; j >>= 1)
#pragma unroll
        for (int i = 0; i < 16; ++i) { const int l = i ^ j; if (l > i) ce_desc(v[i], v[l]); }
}
__device__ __forceinline__ void merge_top16(float (&a)[16], const float (&b)[16]) {
#pragma unroll
    for (int i = 0; i < 16; ++i) a[i] = __builtin_fmaxf(a[i], b[15 - i]);
    bitonic_merge_desc16(a);
}
__device__ __forceinline__ void ce2_desc(float& av, int& ai, float& bv, int& bi) {
    float hv; int hi;
    asm("v_cmp_lt_f32 vcc, %4, %1\n\tv_cndmask_b32 %0, %4, %1, vcc\n\tv_cndmask_b32 %2, %5, %3, vcc\n\tv_cndmask_b32 %1, %1, %4, vcc\n\tv_cndmask_b32 %3, %3, %5, vcc"
        : "=&v"(hv), "+v"(bv), "=&v"(hi), "+v"(bi) : "v"(av), "v"(ai) : "vcc");
    av = hv; ai = hi;
}
__device__ __forceinline__ void bitonic_merge2_desc16(float (&v)[16], int (&p)[16]) {
#pragma unroll
    for (int j = 8; j > 0; j >>= 1)
#pragma unroll
        for (int i = 0; i < 16; ++i) { const int l = i ^ j; if (l > i) ce2_desc(v[i], p[i], v[l], p[l]); }
}
__device__ __forceinline__ void bitonic_sort2_desc16(float (&v)[16], int (&p)[16]) {
#pragma unroll
    for (int k = 2; k <= 16; k <<= 1)
#pragma unroll
        for (int j = k >> 1; j > 0; j >>= 1)
#pragma unroll
            for (int i = 0; i < 16; ++i) { const int l = i ^ j; if (l > i) { if ((i & k) == 0) ce2_desc(v[i], p[i], v[l], p[l]); else ce2_desc(v[l], p[l], v[i], p[i]); } }
}
__device__ __forceinline__ void merge2_top16(float (&av)[16], int (&ap)[16], const float (&bv)[16], const int (&bp)[16]) {
#pragma unroll
    for (int i = 0; i < 16; ++i) { asm("v_cmp_lt_f32 vcc, %0, %2\n\tv_cndmask_b32 %0, %0, %2, vcc\n\tv_cndmask_b32 %1, %1, %3, vcc" : "+v"(av[i]), "+v"(ap[i]) : "v"(bv[15 - i]), "v"(bp[15 - i]) : "vcc"); }
    bitonic_merge2_desc16(av, ap);
}
__device__ __forceinline__ double mk64(float v, int p) { return __builtin_bit_cast(double, ((unsigned long long)__float_as_uint(v) << 32) | (unsigned long long)(unsigned)p); }
__device__ __forceinline__ double max64(double a, double b) { double r; asm("v_max_f64 %0, %1, %2" : "=v"(r) : "v"(a), "v"(b)); return r; }
__device__ __forceinline__ double min64(double a, double b) { double r; asm("v_min_f64 %0, %1, %2" : "=v"(r) : "v"(a), "v"(b)); return r; }
__device__ __forceinline__ void ce_desc_d(double& a, double& b) { const double hi = max64(a, b), lo = min64(a, b); a = hi; b = lo; }
__device__ __forceinline__ void bitonic_merge_desc16_d(double (&v)[16]) {
#pragma unroll
    for (int j = 8; j > 0; j >>= 1)
#pragma unroll
        for (int i = 0; i < 16; ++i) { const int l = i ^ j; if (l > i) ce_desc_d(v[i], v[l]); }
}
__device__ __forceinline__ void bitonic_sort_desc16_d(double (&v)[16]) {
#pragma unroll
    for (int k = 2; k <= 16; k <<= 1)
#pragma unroll
        for (int j = k >> 1; j > 0; j >>= 1)
#pragma unroll
            for (int i = 0; i < 16; ++i) { const int l = i ^ j; if (l > i) { if ((i & k) == 0) ce_desc_d(v[i], v[l]); else ce_desc_d(v[l], v[i]); } }
}
__device__ __forceinline__ void merge_top16_d(double (&a)[16], const double (&b)[16]) {
#pragma unroll
    for (int i = 0; i < 16; ++i) a[i] = max64(a[i], b[15 - i]);
    bitonic_merge_desc16_d(a);
}
constexpr int RT_STRIDE = 544;
struct EpiRoute {
    static constexpr bool PERM = true, AFTER_DRAIN = true;
    unsigned char* ws; int layer;
    int mode; Unit prev;
    __device__ __forceinline__ void half_top16(const f32x4 (&s)[8], int fq, float (&top)[16]) const {
        float lo[16], hi[16];
#pragma unroll
        for (int n = 0; n < 4; ++n)
#pragma unroll
            for (int j = 0; j < 4; ++j) {
                lo[n * 4 + j] = __uint_as_float((__float_as_uint(s[n][j]) & ~127u) | (unsigned)(16 * n + 4 * fq + j));
                hi[n * 4 + j] = __uint_as_float((__float_as_uint(s[n + 4][j]) & ~127u) | (unsigned)(16 * (n + 4) + 4 * fq + j)); }
        bitonic_sort_desc<16>(lo); bitonic_sort_desc<16>(hi); merge_top16(lo, hi);
#pragma unroll
        for (int st = 16; st <= 32; st <<= 1) { float o[16];
#pragma unroll
            for (int i = 0; i < 16; ++i) o[i] = __shfl_xor(lo[i], st);
            merge_top16(lo, o); }
#pragma unroll
        for (int i = 0; i < 16; ++i) top[i] = lo[i];
    }
    __device__ __forceinline__ void fused(f32x4 (&acc)[2][2][4][2], const Unit& u, int wr, int wc, int fr, int fq, PG8_LAS unsigned char* lds, int wid, int lane) const {
        const int hp = u.pn; const float* part = (const float*)(ws + WS_PART); const bf16_t* keys = (const bf16_t*)(ws + WS_PKEY) + (size_t)layer * 8 * 2 * 128 * 128; int* idx = (int*)(ws + WS_IDX); float* gate = (float*)(ws + WS_GATE);
        constexpr int KOFF = 128 * RT_STRIDE, KSTRIDE = 288;
        { const int tid = wid * 64 + lane; const bf16_t* kh = keys + (size_t)hp * 2 * 128 * 128;
#pragma unroll
          for (int i = 0; i < 8; ++i) { const int q = tid + 512 * i, kr = q >> 4, c = q & 15; *(PG8_LAS u32x4*)(lds + KOFF + kr * KSTRIDE + c * 16) = *(const u32x4*)(kh + (size_t)kr * 128 + c * 8); } }
        float ta0[16], tb0[16], ta1[16], tb1[16];
        f32x4* stash = (f32x4*)(ws + WS_STASH) + ((size_t)blockIdx.x * 8 + wid) * 256;
        f32x4 sa[4], sb[4];
#pragma unroll
        for (int i = 0; i < 4; ++i) { sa[i] = (f32x4){0.f, 0.f, 0.f, 0.f}; sb[i] = sa[i]; }
#pragma unroll
        for (int ai = 0; ai < 2; ++ai) {
#pragma unroll
            for (int m = 0; m < 4; ++m) { const int rl = wr * 64 + m * 16 + fr; const float rs = row_rstd(part, u.pm * BM + ai * HALF + rl, fq);
#pragma unroll
                for (int bj = 0; bj < 2; ++bj) { const f32x4 a = acc[ai][bj][m][0] * rs, b = acc[ai][bj][m][1] * rs;
                    u32x4 w; w.x = pk_bf16(a[0], a[1]); w.y = pk_bf16(a[2], a[3]); w.z = pk_bf16(b[0], b[1]); w.w = pk_bf16(b[2], b[3]);
                    *(PG8_LAS u32x4*)(lds + rl * RT_STRIDE + (64 * wc + 32 * bj + 8 * fq) * 2) = w; } }
            asm volatile("s_waitcnt vmcnt(0) lgkmcnt(0)" ::: "memory"); __builtin_amdgcn_s_barrier(); asm volatile("" ::: "memory");
            if (ai == 1 && mode == 2) {
#pragma unroll
                for (int i = 0; i < 4; ++i) { sa[i] = stash[((fq & 1) * 2 + 0) * 64 + fr * 4 + i]; sb[i] = stash[((fq & 1) * 2 + 1) * 64 + fr * 4 + i]; } }
            const int rl = 16 * wid + fr;
#pragma unroll
            for (int p = 0; p < 2; ++p) {
                f32x4 s[8];
#pragma unroll
                for (int n = 0; n < 8; ++n) s[n] = (f32x4){0.f, 0.f, 0.f, 0.f};
#pragma unroll
                for (int kk = 0; kk < 4; ++kk) {
                    const bf16x8 qf = *(const PG8_LAS bf16x8*)(lds + rl * RT_STRIDE + (p * 128 + 32 * kk + 8 * fq) * 2);
#pragma unroll
                    for (int n = 0; n < 8; ++n) { const bf16x8 kf = *(const PG8_LAS bf16x8*)(lds + KOFF + (p * 128 + 16 * n + fr) * KSTRIDE + (32 * kk + 8 * fq) * 2);
                        s[n] = __builtin_amdgcn_mfma_f32_16x16x32_bf16(kf, qf, s[n], 0, 0, 0); } }
                if (ai == 0) { if (p == 0) half_top16(s, fq, ta0); else half_top16(s, fq, tb0); } else { if (p == 0) half_top16(s, fq, ta1); else half_top16(s, fq, tb1); }
            }
            asm volatile("s_waitcnt lgkmcnt(0)" ::: "memory"); __builtin_amdgcn_s_barrier(); asm volatile("" ::: "memory");
        }
        if (mode == 1) {
            if (fq == 0) {
#pragma unroll
                for (int i = 0; i < 4; ++i) {
                    stash[0 * 64 + fr * 4 + i] = (f32x4){ta0[4 * i], ta0[4 * i + 1], ta0[4 * i + 2], ta0[4 * i + 3]}; stash[1 * 64 + fr * 4 + i] = (f32x4){tb0[4 * i], tb0[4 * i + 1], tb0[4 * i + 2], tb0[4 * i + 3]};
                    stash[2 * 64 + fr * 4 + i] = (f32x4){ta1[4 * i], ta1[4 * i + 1], ta1[4 * i + 2], ta1[4 * i + 3]}; stash[3 * 64 + fr * 4 + i] = (f32x4){tb1[4 * i], tb1[4 * i + 1], tb1[4 * i + 2], tb1[4 * i + 3]}; } }
            return;
        }
        {
            const int aisel = fq & 1; const bool useprev = mode == 2 && fq < 2; const bool active = mode == 2 || fq < 2;
            const int upm = useprev ? prev.pm : u.pm, hpx = useprev ? prev.pn : hp;
            const int row = upm * BM + aisel * HALF + 16 * wid + fr;
            float ta[16], tb[16];
#pragma unroll
            for (int i = 0; i < 16; ++i) { float a0 = ta0[i], a1 = ta1[i], b0 = tb0[i], b1 = tb1[i], pa = sa[i >> 2][i & 3], pb = sb[i >> 2][i & 3]; asm volatile("" : "+v"(a0), "+v"(a1), "+v"(b0), "+v"(b1), "+v"(pa), "+v"(pb));
                const float xa = aisel ? a1 : a0, xb = aisel ? b1 : b0; ta[i] = useprev ? pa : xa; tb[i] = useprev ? pb : xb; }
            int ka[16], kb[16];
#pragma unroll
            for (int i = 0; i < 16; ++i) { ka[i] = (int)(__float_as_uint(ta[i]) & 127u) << 7; kb[i] = (int)(__float_as_uint(tb[i]) & 127u); }
            double d1[16], d2[16];
#pragma unroll
            for (int j = 0; j < 16; ++j) d1[j] = mk64(ta[0] + tb[j], ka[0] | kb[j]);
#pragma unroll
            for (int j = 0; j < 8; ++j) { d2[j] = mk64(ta[1] + tb[j], ka[1] | kb[j]); d2[8 + j] = mk64(ta[15 - j] + tb[0], ka[15 - j] | kb[0]); }
            bitonic_merge_desc16_d(d2);
            merge_top16_d(d1, d2);
            {
                constexpr int RI[16] = {2, 2, 2, 2, 2, 3, 3, 3, 3, 4, 4, 4, 5, 5, 6, 6}, RJ[16] = {0, 1, 2, 3, 4, 0, 1, 2, 3, 0, 1, 2, 0, 1, 0, 1};
#pragma unroll
                for (int q = 0; q < 16; ++q) d2[q] = mk64(ta[RI[q]] + tb[RJ[q]], ka[RI[q]] | kb[RJ[q]]);
                bitonic_sort_desc16_d(d2);
                merge_top16_d(d1, d2);
            }
#pragma unroll
            for (int jj = 0; jj < 2; ++jj) { double c = mk64(ta[7] + tb[jj], ka[7] | kb[jj]);
#pragma unroll
                for (int i = 0; i < 16; ++i) ce_desc_d(d1[i], c); }
            float v1[16]; int p1[16];
#pragma unroll
            for (int i = 0; i < 16; ++i) { const unsigned long long w = __builtin_bit_cast(unsigned long long, d1[i]); v1[i] = __uint_as_float((unsigned)(w >> 32)); p1[i] = (int)(unsigned)w; }
            float ex[16]; float sum = 0.f;
#pragma unroll
            for (int i = 0; i < 16; ++i) { ex[i] = __builtin_amdgcn_exp2f((v1[i] - v1[0]) * K_LOG2E); sum += ex[i]; }
            const float inv = __builtin_amdgcn_rcpf(sum);
            if (active) {
                int* ip = idx + (size_t)row * 128 + hpx * 16; float* gp = gate + (size_t)row * 128 + hpx * 16;
#pragma unroll
                for (int i = 0; i < 16; i += 4) { typedef int i32x4 __attribute__((ext_vector_type(4)));
                    *(i32x4*)(ip + i) = (i32x4){p1[i], p1[i + 1], p1[i + 2], p1[i + 3]};
                    *(f32x4*)(gp + i) = (f32x4){ex[i] * inv, ex[i + 1] * inv, ex[i + 2] * inv, ex[i + 3] * inv}; }
            }
        }
    }
};
struct OneUnit {
    StaticOrderT<2048> S; int k;
    __device__ __forceinline__ bool next(int i, Unit& u) const { return i == 0 ? S.next(k, u) : false; }
    __device__ __forceinline__ void a_ready(const Unit&) const {}
    __device__ __forceinline__ void done(const Unit&) const {}
};
template <class Epi, class Sched, bool ALIGN_EPI = false, bool SP2 = false>
__device__ __forceinline__ void gemm_phase(PG8_LAS unsigned char* lds, const Gemm g, const Sched& S, const Epi& E) {
    int tid_ = threadIdx.x; asm volatile("" : "+v"(tid_));
    const int tid = tid_, wid = __builtin_amdgcn_readfirstlane(tid >> 6), lane = tid & 63, wr = wid >> 2, wc = wid & 3, fr = lane & 15, fq = lane >> 4;
    constexpr int K = 1024, nt = K / BK;
    unsigned voffA[2], voffB[2];
#pragma unroll
    for (int i = 0; i < 2; ++i) { int R, C; stage_rc(tid * 16 + i * 8192, R, C); const int Rb = Epi::PERM ? ((R & ~31) + perm32(R & 31)) : R;
        voffA[i] = (unsigned)(R * K + C) * 2u; voffB[i] = (unsigned)(Rb * K + C) * 2u; }
    const size_t kstep = (size_t)(BK * 2);
    const size_t hstep = (size_t)HALF * K * 2;
    const size_t tstep = 2 * hstep;
    const unsigned ldsw = (unsigned)wid * 1024u;
    const int aoff = lds_byte(wr * 64 + fr, fq * 8), boff = lds_byte(wc * 32 + fr, fq * 8);
#define PG8_SA(b, h) (((b) * 2 + (h)) * HTB)
#define PG8_SB(b, h) ((4 + (b) * 2 + (h)) * HTB)
#define PG8_STAGE(bufoff, gbase, voff) do { _Pragma("unroll") for (int _i = 0; _i < 2; ++_i) \
        __builtin_amdgcn_global_load_lds((const unsigned*)((const char*)(gbase) + (voff)[_i]), (PG8_LAS unsigned*)(lds + (bufoff) + ldsw + _i * 8192), 16, 0, 0); } while (0)
#define PG8_LDA(dst, b, h) do { _Pragma("unroll") for (int m = 0; m < 4; ++m) _Pragma("unroll") for (int k = 0; k < 2; ++k) dst[m][k] = *(const PG8_LAS bf16x8*)(lds + PG8_SA(b, h) + aoff + m * 2048 + k * 1024); } while (0)
#define PG8_LDB(dst, b, h) do { _Pragma("unroll") for (int n = 0; n < 2; ++n) _Pragma("unroll") for (int k = 0; k < 2; ++k) dst[n][k] = *(const PG8_LAS bf16x8*)(lds + PG8_SB(b, h) + boff + n * 2048 + k * 1024); } while (0)
#define PG8_MMA(ai, bj, At, Bt) do { __builtin_amdgcn_s_setprio(1); _Pragma("unroll") for (int m = 0; m < 4; ++m) _Pragma("unroll") for (int n = 0; n < 2; ++n) _Pragma("unroll") for (int k = 0; k < 2; ++k) \
        acc[ai][bj][m][n] = __builtin_amdgcn_mfma_f32_16x16x32_bf16(Bt[n][k], At[m][k], acc[ai][bj][m][n], 0, 0, 0); __builtin_amdgcn_s_setprio(0); } while (0)
#define PG8_WAIT_V(n) asm volatile("s_waitcnt vmcnt(" #n ")" ::: "memory")
#define PG8_WAIT_L(n) asm volatile("s_waitcnt lgkmcnt(" #n ")" ::: "memory")
#define PG8_BAR __builtin_amdgcn_s_barrier()
#define PG8_SCHED __builtin_amdgcn_sched_barrier(0)
    Unit cur, nxt; int ui = 0;
    if (!S.next(0, cur)) return;
    f32x4 acc[2][2][4][2];
#pragma unroll
    for (int a = 0; a < 2; ++a)
#pragma unroll
        for (int b = 0; b < 2; ++b)
#pragma unroll
            for (int m = 0; m < 4; ++m)
#pragma unroll
                for (int n = 0; n < 2; ++n) acc[a][b][m][n] = (f32x4){0.f, 0.f, 0.f, 0.f};
    bf16x8 At[4][2], B0[2][2], B1[2][2];
    const char* cA = (const char*)g.A + (size_t)cur.pm * tstep; const char* cB = (const char*)g.Bt + (size_t)cur.pn * tstep;
    S.a_ready(cur);
    if constexpr (SP2) {
        PG8_STAGE(PG8_SB(0, 0), cB, voffB); PG8_STAGE(PG8_SB(0, 1), cB + hstep, voffB); PG8_STAGE(PG8_SA(0, 0), cA, voffA); PG8_STAGE(PG8_SA(0, 1), cA + hstep, voffA);
        if (wr == 1) PG8_BAR;
        PG8_WAIT_V(2); PG8_BAR;
        PG8_STAGE(PG8_SB(1, 0), cB + kstep, voffB); PG8_STAGE(PG8_SA(1, 0), cA + kstep, voffA); PG8_STAGE(PG8_SB(1, 1), cB + hstep + kstep, voffB);
        PG8_WAIT_V(6); PG8_BAR;
    } else {
        PG8_STAGE(PG8_SB(0, 0), cB, voffB); PG8_STAGE(PG8_SA(0, 0), cA, voffA); PG8_STAGE(PG8_SB(0, 1), cB + hstep, voffB); PG8_STAGE(PG8_SA(0, 1), cA + hstep, voffA);
        if (wr == 1) PG8_BAR;
        PG8_WAIT_V(4); PG8_BAR;
        PG8_STAGE(PG8_SB(1, 0), cB + kstep, voffB); PG8_STAGE(PG8_SA(1, 0), cA + kstep, voffA); PG8_STAGE(PG8_SB(1, 1), cB + hstep + kstep, voffB);
        PG8_WAIT_V(6); PG8_BAR;
    }
    for (;;) {
        const bool has_next = S.next(ui + 1, nxt);
        const char* nA = has_next ? (const char*)g.A + (size_t)nxt.pm * tstep : cA; const char* nB = has_next ? (const char*)g.Bt + (size_t)nxt.pn * tstep : cB;
        for (int t = 0; t < nt; t += 2) {
            const bool last = (t == nt - 2);
            const char* a1 = cA + (size_t)(t + 1) * kstep;
            const char* a2 = last ? nA : cA + (size_t)(t + 2) * kstep; const char* b2 = last ? nB : cB + (size_t)(t + 2) * kstep;
            const char* a3 = a2 + kstep; const char* b3 = b2 + kstep;
            if (last && has_next) S.a_ready(nxt);
            if constexpr (SP2) {
            PG8_LDB(B0, 0, 0); PG8_LDB(B1, 0, 1); PG8_SCHED; PG8_LDA(At, 0, 0); PG8_STAGE(PG8_SA(1, 1), a1 + hstep, voffA);
            PG8_WAIT_V(8); PG8_WAIT_L(0); PG8_BAR; PG8_MMA(0, 0, At, B0); PG8_MMA(0, 1, At, B1); PG8_BAR; PG8_SCHED;
            PG8_LDA(At, 0, 1); PG8_STAGE(PG8_SB(0, 0), b2, voffB); PG8_STAGE(PG8_SB(0, 1), b2 + hstep, voffB); PG8_STAGE(PG8_SA(0, 0), a2, voffA);
            PG8_WAIT_V(8); PG8_WAIT_L(0); PG8_BAR; PG8_MMA(1, 0, At, B0); PG8_MMA(1, 1, At, B1); PG8_BAR; PG8_SCHED;
            PG8_LDB(B0, 1, 0); PG8_LDB(B1, 1, 1); PG8_SCHED; PG8_LDA(At, 1, 0); PG8_STAGE(PG8_SA(0, 1), a2 + hstep, voffA);
            PG8_WAIT_V(8); PG8_WAIT_L(0); PG8_BAR; PG8_MMA(0, 0, At, B0); PG8_MMA(0, 1, At, B1); PG8_BAR; PG8_SCHED;
            PG8_LDA(At, 1, 1); PG8_STAGE(PG8_SB(1, 0), b3, voffB); PG8_STAGE(PG8_SB(1, 1), b3 + hstep, voffB); PG8_STAGE(PG8_SA(1, 0), a3, voffA);
            PG8_WAIT_V(8); PG8_WAIT_L(0); PG8_BAR; PG8_MMA(1, 0, At, B0); PG8_MMA(1, 1, At, B1); PG8_BAR; PG8_SCHED;
            } else {
            PG8_LDB(B0, 0, 0); PG8_SCHED; PG8_LDA(At, 0, 0); PG8_STAGE(PG8_SA(1, 1), a1 + hstep, voffA);
            PG8_WAIT_L(8); PG8_BAR; PG8_WAIT_L(0); PG8_MMA(0, 0, At, B0); PG8_BAR; PG8_SCHED;
            PG8_LDB(B1, 0, 1); PG8_STAGE(PG8_SB(0, 0), b2, voffB);
            PG8_BAR; PG8_WAIT_L(0); PG8_MMA(0, 1, At, B1); PG8_BAR;
            PG8_LDA(At, 0, 1); PG8_STAGE(PG8_SA(0, 0), a2, voffA);
            PG8_BAR; PG8_WAIT_L(0); PG8_MMA(1, 0, At, B0); PG8_BAR; PG8_SCHED;
            PG8_STAGE(PG8_SB(0, 1), b2 + hstep, voffB);
            PG8_WAIT_V(6); PG8_BAR; PG8_MMA(1, 1, At, B1); PG8_BAR;
            PG8_LDB(B0, 1, 0); PG8_SCHED; PG8_LDA(At, 1, 0); PG8_STAGE(PG8_SA(0, 1), a2 + hstep, voffA);
            PG8_WAIT_L(8); PG8_BAR; PG8_WAIT_L(0); PG8_MMA(0, 0, At, B0); PG8_BAR; PG8_SCHED;
            PG8_LDB(B1, 1, 1); PG8_STAGE(PG8_SB(1, 0), b3, voffB);
            PG8_BAR; PG8_WAIT_L(0); PG8_MMA(0, 1, At, B1); PG8_BAR;
            PG8_LDA(At, 1, 1); PG8_STAGE(PG8_SA(1, 0), a3, voffA);
            PG8_BAR; PG8_WAIT_L(0); PG8_MMA(1, 0, At, B0); PG8_BAR; PG8_SCHED;
            PG8_STAGE(PG8_SB(1, 1), b3 + hstep, voffB);
            PG8_WAIT_V(6); PG8_BAR; PG8_MMA(1, 1, At, B1); PG8_BAR;
            }
        }
        if constexpr (ALIGN_EPI) { if (wr == 0) PG8_BAR; }
        if constexpr (!Epi::AFTER_DRAIN) { E(acc, cur, wr, wc, fr, fq); S.done(cur); }
        if (!has_next) break;
#pragma unroll
        for (int a = 0; a < 2; ++a)
#pragma unroll
            for (int b = 0; b < 2; ++b)
#pragma unroll
                for (int m = 0; m < 4; ++m)
#pragma unroll
                    for (int n = 0; n < 2; ++n) acc[a][b][m][n] = (f32x4){0.f, 0.f, 0.f, 0.f};
        cur = nxt; cA = nA; cB = nB; ++ui;
        if constexpr (ALIGN_EPI) { if (wr == 1) PG8_BAR; }
    }
    PG8_WAIT_V(0);
    if constexpr (!ALIGN_EPI) { if (wr == 0) PG8_BAR; }
    PG8_BAR;
    if constexpr (Epi::AFTER_DRAIN) { E.fused(acc, cur, wr, wc, fr, fq, lds, wid, lane); S.done(cur); }
#undef PG8_SA
#undef PG8_SB
#undef PG8_STAGE
#undef PG8_LDA
#undef PG8_LDB
#undef PG8_MMA
#undef PG8_WAIT_V
#undef PG8_WAIT_L
#undef PG8_BAR
#undef PG8_SCHED
}
}
namespace attn_body {
using bf16=__hip_bfloat16;
using bf16x8=__attribute__((ext_vector_type(8)))short;
using s16x4=__attribute__((ext_vector_type(4)))short;
using f32x16=__attribute__((ext_vector_type(16)))float;
using u32x4=__attribute__((ext_vector_type(4)))unsigned;
constexpr int BATCH=8,NHEAD=16,SEQ=2048,D=64,DM=NHEAD*D,OPITCH=2048;
constexpr int NW=8,QBLK=32,QB=QBLK*NW,KVBLK=64,NQB=SEQ/QB;
constexpr int ATTN_PITCH=DM, ATTN_UNIT_ROWS=QB;
__device__ __forceinline__ int crow(int r,int hi){return (r&3)+8*(r>>2)+4*hi;}
#define SBAR() __builtin_amdgcn_sched_barrier(0)
__device__ __forceinline__ void cmask(f32x16&p0,f32x16&p1,int jb,int qrel,int hi){
  const float NEG=-INFINITY; int kb=64*jb+4*hi;
  #pragma unroll
  for(int r=0;r<16;++r){int kv=kb+(r&3)+8*(r>>2); if(kv>qrel)p0[r]=NEG; if(kv+32>qrel)p1[r]=NEG;}
}

typedef const __attribute__((address_space(3))) float* lds_fptr;
__device__ __forceinline__ void bias_init1(f32x16&c,int sel,int jb,int qrel,int hi,lds_fptr bt,const f32x16&negm){
  const lds_fptr b=bt+(256+qrel-64*jb-4*hi-32*sel);
  #pragma unroll
  for(int r=0;r<16;++r){const int off=(r&3)+8*(r>>2); c[r]=b[-off]+negm[r];}
}
constexpr int NSLOT=3, SLOTB=8192;
constexpr int NVSLOT=4, VSLOTB=16384;
constexpr int LDS_K=0, LDS_V=NSLOT*SLOTB, LDS_WS=LDS_V+NVSLOT*VSLOTB, LDS_OST=LDS_WS+NW*64*4, LDS_BYTES=LDS_OST+NW*4096;
constexpr float C2=0.125f*1.4426950408889634f;
__device__ __forceinline__ void glds16(const void*gsrc,unsigned lds_dst){unsigned keep;
  asm volatile("s_mov_b32 %0, m0\n\ts_mov_b32 m0, %2\n\ts_nop 0\n\tglobal_load_lds_dwordx4 %1, off\n\ts_mov_b32 m0, %0":"=&s"(keep):"v"(gsrc),"s"(lds_dst):"memory");}
__device__ __forceinline__ float max3f(float a,float b,float c){float r;asm("v_max3_f32 %0, %1, %2, %3":"=v"(r):"v"(a),"v"(b),"v"(c));return r;}
__device__ __forceinline__ float max2f(float a,float b){float r;asm("v_max_f32_e32 %0, %1, %2":"=v"(r):"v"(a),"v"(b));return r;}
__device__ __forceinline__ float fadd_s(float a,float b){float r;asm("v_add_f32_e32 %0, %1, %2":"=v"(r):"v"(a),"v"(b));return r;}
__device__ __forceinline__ float fsub_s(float a,float b){float r;asm("v_sub_f32_e32 %0, %1, %2":"=v"(r):"v"(a),"v"(b));return r;}
typedef float f32x2_t __attribute__((ext_vector_type(2))); typedef __bf16 bf16x2_t __attribute__((ext_vector_type(2)));
__device__ __forceinline__ unsigned cvtpk_s(float lo,float hi){f32x2_t v={lo,hi};bf16x2_t b=__builtin_convertvector(v,bf16x2_t);return __builtin_bit_cast(unsigned,b);}
#define WAIT_BAR(N) asm volatile("s_waitcnt vmcnt(" #N ") lgkmcnt(0)\n\ts_barrier":::"memory")

__device__ __forceinline__ void qkt(f32x16&p0,f32x16&p1,const char*Kslot,const bf16x8*qr,const f32x16&ci0,const f32x16&ci1,int r32,int hi){
  const char*kb=Kslot+hi*1024+r32*16;
  #pragma unroll
  for(int d0=0;d0<4;++d0){
    const bf16x8 b0=*reinterpret_cast<const bf16x8*>(kb+d0*2048);
    const bf16x8 b1=*reinterpret_cast<const bf16x8*>(kb+d0*2048+512);
    if(d0==0){p0=__builtin_amdgcn_mfma_f32_32x32x16_bf16(b0,qr[0],ci0,0,0,0);p1=__builtin_amdgcn_mfma_f32_32x32x16_bf16(b1,qr[0],ci1,0,0,0);}
    else{p0=__builtin_amdgcn_mfma_f32_32x32x16_bf16(b0,qr[d0],p0,0,0,0);p1=__builtin_amdgcn_mfma_f32_32x32x16_bf16(b1,qr[d0],p1,0,0,0);}}
}
typedef __attribute__((address_space(3))) const char* lds_cptr;
typedef short v4i16_t __attribute__((ext_vector_type(4)));
__device__ __forceinline__ void kload8(bf16x8*kf,lds_cptr kp){
  kf[0]=*(const __attribute__((address_space(3))) bf16x8*)(kp);      kf[1]=*(const __attribute__((address_space(3))) bf16x8*)(kp+512);
  kf[2]=*(const __attribute__((address_space(3))) bf16x8*)(kp+2048); kf[3]=*(const __attribute__((address_space(3))) bf16x8*)(kp+2560);
  kf[4]=*(const __attribute__((address_space(3))) bf16x8*)(kp+4096); kf[5]=*(const __attribute__((address_space(3))) bf16x8*)(kp+4608);
  kf[6]=*(const __attribute__((address_space(3))) bf16x8*)(kp+6144); kf[7]=*(const __attribute__((address_space(3))) bf16x8*)(kp+6656);
}
__device__ __forceinline__ void kload2(bf16x8*kf,lds_cptr kp,int j){ kf[2*j]=*(const __attribute__((address_space(3))) bf16x8*)(kp+j*2048); kf[2*j+1]=*(const __attribute__((address_space(3))) bf16x8*)(kp+j*2048+512); }
__device__ __forceinline__ s16x4 vtr(lds_cptr p){ return __builtin_bit_cast(s16x4,__builtin_amdgcn_ds_read_tr16_b64_v4i16((__attribute__((address_space(3))) v4i16_t*)p)); }
__device__ __forceinline__ float rowmax(const f32x16&p0,const f32x16&p1){
  float a=max3f(p0[0],p0[1],p1[0]),b=max3f(p0[2],p0[3],p1[1]);a=max3f(a,p1[2],p1[3]);
  #pragma unroll
  for(int r=4;r<16;r+=4){a=max3f(a,p0[r],p0[r+1]);b=max3f(b,p0[r+2],p0[r+3]);a=max3f(a,p1[r],p1[r+1]);b=max3f(b,p1[r+2],p1[r+3]);}
  const float m=max2f(a,b);
  auto rr=__builtin_amdgcn_permlane32_swap(__float_as_uint(m),__float_as_uint(m),false,false);
  return max2f(__uint_as_float(rr[0]),__uint_as_float(rr[1]));
}
__device__ __forceinline__ void pv(f32x16*o,int vb,bf16x8 pa0,bf16x8 pa1,bf16x8 pa2,bf16x8 pa3){
  #pragma unroll
  for(int d0=0;d0<4;++d0){s16x4 lo[4],hi[4];
    #pragma unroll
    for(int ks=0;ks<4;++ks){
      asm volatile("ds_read_b64_tr_b16 %0,%1 offset:%c2":"=&v"(lo[ks]):"v"(vb),"i"(d0*4096+ks*1024):"memory");
      asm volatile("ds_read_b64_tr_b16 %0,%1 offset:%c2":"=&v"(hi[ks]):"v"(vb),"i"(d0*4096+ks*1024+512):"memory");}
    asm volatile("s_waitcnt lgkmcnt(0)":::"memory");SBAR();
    #define PK(k) (bf16x8){lo[k][0],lo[k][1],lo[k][2],lo[k][3],hi[k][0],hi[k][1],hi[k][2],hi[k][3]}
    o[d0]=__builtin_amdgcn_mfma_f32_32x32x16_bf16(pa0,PK(0),o[d0],0,0,0);
    o[d0]=__builtin_amdgcn_mfma_f32_32x32x16_bf16(pa1,PK(1),o[d0],0,0,0);
    o[d0]=__builtin_amdgcn_mfma_f32_32x32x16_bf16(pa2,PK(2),o[d0],0,0,0);
    o[d0]=__builtin_amdgcn_mfma_f32_32x32x16_bf16(pa3,PK(3),o[d0],0,0,0);
    #undef PK
  }
}

#ifndef ATTN_STORE16
#define ATTN_STORE16(p,v) do{ asm volatile("global_store_dwordx4 %0, %1, off sc0 sc1\n\ts_nop 1"::"v"(p),"v"(v):"memory"); }while(0)
#endif
template<int THRL> __device__ __forceinline__ void attn_unit(int b,int hq,int hv,int ho,int qb,const bf16*Q,const bf16*__restrict__ K,const bf16*__restrict__ V,bf16*O,char*shm,lds_fptr btab){
  int tid_=threadIdx.x; asm volatile("":"+v"(tid_)); const int tid=tid_,lane=tid&63,r32=lane&31,hi=lane>>5; const int wid=__builtin_amdgcn_readfirstlane(tid>>6);
  const long rowbase=(long)b*SEQ; const int q0=qb*QB;
  const bf16*Qw=Q+(rowbase+q0+wid*QBLK)*DM+hq*D;
  const bf16*Kh=K+rowbase*DM+hq*D,*Vh=V+rowbase*DM+hv*D;
  const unsigned lds0=(unsigned)(uintptr_t)shm;
  float*wsf=(float*)(shm+LDS_WS)+wid*64;
  const bf16*ksrc=Kh+(long)lane*DM+wid*8;
  const bf16*vsrc=Vh+(long)(16*(wid&3)+(lane>>2))*DM+(wid>>2)*32+(lane&3)*8;
  const unsigned kdst=lds0+LDS_K+wid*1024, vdst=lds0+LDS_V+wid*1024;
  #define DMA_K(t,slot) glds16(ksrc+(long)(t)*KVBLK*DM,(unsigned)__builtin_amdgcn_readfirstlane(kdst+(slot)))
  #define VSL(t) ((((t))&(NVSLOT-1))*VSLOTB)
  #define DMA_V(t) do{ glds16(vsrc+(long)(t)*KVBLK*DM,(unsigned)__builtin_amdgcn_readfirstlane(vdst+VSL(t))); glds16(vsrc+(long)(t)*KVBLK*DM+64,(unsigned)__builtin_amdgcn_readfirstlane(vdst+VSL(t)+8192)); }while(0)
  const int vb0=(int)(lds0+LDS_V)+((lane>>4)&1)*32+(lane&3)*8+(4*hi+((lane&15)>>2))*64;
  const char*Kbase=shm+LDS_K; bf16x8 kf[8];
  const lds_cptr shm3=(lds_cptr)shm; const lds_cptr kp0=shm3+LDS_K+hi*1024+r32*16; const lds_cptr vp0=shm3+LDS_V+((lane>>4)&1)*32+(lane&3)*8+(4*hi+((lane&15)>>2))*64;
  const int NT=(q0+QB)/KVBLK;
  DMA_K(0,0);DMA_V(0);DMA_K(1,SLOTB);
  bf16x8 qr[4];
  #pragma unroll
  for(int d0=0;d0<4;++d0)qr[d0]=*reinterpret_cast<const bf16x8*>(&Qw[(long)r32*DM+d0*16+hi*8]);
  float mhat=0.f,l_reg=0.f;f32x16 o[4];o[0]=f32x16{};o[1]=f32x16{};o[2]=f32x16{};o[3]=f32x16{};f32x16 negm=f32x16{};asm volatile("":"+v"(negm));
  const int qrel=wid*QBLK+r32;
  #define CMASK(P0,P1,t) do{int jb_=(t)-(NT-4); if(jb_>=0)cmask(P0,P1,jb_,qrel,hi);}while(0)
  bool resc=false;
  #define START(P0,P1) do{ const float rm=rowmax(P0,P1); resc=false; \
    { const float dl=rm; mhat=fadd_s(mhat,dl); \
      _Pragma("unroll") for(int r=0;r<16;++r){P0[r]=fsub_s(P0[r],dl);P1[r]=fsub_s(P1[r],dl);} \
      _Pragma("unroll") for(int r=0;r<16;++r)negm[r]=-mhat; asm volatile("":"+v"(negm)); } \
    _Pragma("unroll") for(int r=0;r<16;++r)P0[r]=__builtin_amdgcn_exp2f(P0[r]); }while(0)
  #define RESC() do{ if(resc){ asm volatile("s_waitcnt lgkmcnt(0)":::"memory"); \
      _Pragma("unroll") for(int d_=0;d_<4;++d_) _Pragma("unroll") for(int r=0;r<16;++r)o[d_][r]*=wsf[crow(r,hi)]; } }while(0)
  f32x16 pA0,pA1;
  int sl_prev=0,sl_cur=0,sl_next=SLOTB;
  #define ROT() do{sl_prev=sl_cur;sl_cur=sl_next;sl_next=(sl_next==(NSLOT-1)*SLOTB)?0:sl_next+SLOTB;}while(0)
  DMA_K(2,2*SLOTB);DMA_V(1);
  WAIT_BAR(6);
  if(NT==4){ f32x16 cb0,cb1; bias_init1(cb0,0,0,qrel,hi,btab,negm); bias_init1(cb1,1,0,qrel,hi,btab,negm); qkt(pA0,pA1,Kbase,qr,cb0,cb1,r32,hi); } else qkt(pA0,pA1,Kbase,qr,negm,negm,r32,hi);
  asm volatile("s_nop 15\n\ts_nop 7":"+v"(pA0),"+v"(pA1));CMASK(pA0,pA1,0);
  START(pA0,pA1);
  _Pragma("unroll") for(int r=0;r<16;++r)pA1[r]=__builtin_amdgcn_exp2f(pA1[r]);
  u32x4 pw0,pw1,pw2,pw3;
  #define PKW(P,B) cvtpk_s(P[B],P[B+1])
  { float sacc=pA0[0]+pA0[1]; _Pragma("unroll") for(int r=2;r<16;++r)sacc+=pA0[r]; _Pragma("unroll") for(int r=0;r<16;++r)sacc+=pA1[r]; l_reg+=sacc;
    pw0=(u32x4){PKW(pA0,0),PKW(pA0,2),PKW(pA0,4),PKW(pA0,6)};pw1=(u32x4){PKW(pA0,8),PKW(pA0,10),PKW(pA0,12),PKW(pA0,14)};pw2=(u32x4){PKW(pA1,0),PKW(pA1,2),PKW(pA1,4),PKW(pA1,6)};pw3=(u32x4){PKW(pA1,8),PKW(pA1,10),PKW(pA1,12),PKW(pA1,14)}; }
  WAIT_BAR(3);
  DMA_K(3,0);DMA_V(2);
  ROT();
  kload8(kf,kp0+sl_cur);
  WAIT_BAR(5);
  s16x4 vlo[4],vhi[4];
  #define PAF(k) __builtin_bit_cast(bf16x8,pw##k)
  #define VFR(i) (bf16x8){vlo[i][0],vlo[i][1],vlo[i][2],vlo[i][3],vhi[i][0],vhi[i][1],vhi[i][2],vhi[i][3]}
  #define PIN(x) asm volatile("":"+v"(x))
  #define MX3(a,b,c) __builtin_fmaxf(__builtin_fmaxf((a),(b)),(c))
  #define EX(v) __builtin_amdgcn_exp2f(v)
  #define VRD(f) do{ vlo[(f)&3]=vtr(vp_+(((f)&3)*4096+((f)>>2)*1024)); vhi[(f)&3]=vtr(vp_+(((f)&3)*4096+((f)>>2)*1024+512)); }while(0)
  #define KRD(G,j) do{ if(G){ kload2(kf,kp0+sl_next,j); } }while(0)
  #define GAPQ(MF) do{ MF; SBAR(); }while(0)
  #define GAPB(MF,X,B,EXTRA) do{ MF; X[B]=EX(X[B]); X[B+1]=EX(X[B+1]); sacc+=X[B]; sacc+=X[B+1]; EXTRA; PIN(X); PIN(sacc); SBAR(); }while(0)
  #define PVM(j) o[(j)&3]=__builtin_amdgcn_mfma_f32_32x32x16_bf16(PAFJ(j),VFR((j)&3),o[(j)&3],0,0,0)
  #define STEP(C0,C1,t,GK,GV,GL,BZ) do{ SBAR(); \
    const lds_cptr vp_=vp0+VSL((t)-1); \
    if(BZ){ bias_init1(C0,0,(t)-(NT-4),qrel,hi,btab,negm); SBAR(); } \
    GAPQ(C0=__builtin_amdgcn_mfma_f32_32x32x16_bf16(kf[0],qr[0],(BZ)?C0:negm,0,0,0)); \
    if(BZ){ bias_init1(C1,1,(t)-(NT-4),qrel,hi,btab,negm); SBAR(); } \
    GAPQ(C1=__builtin_amdgcn_mfma_f32_32x32x16_bf16(kf[1],qr[0],(BZ)?C1:negm,0,0,0)); \
    GAPQ(C0=__builtin_amdgcn_mfma_f32_32x32x16_bf16(kf[2],qr[1],C0,0,0,0)); \
    GAPQ(C1=__builtin_amdgcn_mfma_f32_32x32x16_bf16(kf[3],qr[1],C1,0,0,0)); \
    VRD(0); SBAR(); GAPQ(C0=__builtin_amdgcn_mfma_f32_32x32x16_bf16(kf[4],qr[2],C0,0,0,0)); \
    VRD(1); SBAR(); GAPQ(C1=__builtin_amdgcn_mfma_f32_32x32x16_bf16(kf[5],qr[2],C1,0,0,0)); \
    VRD(2); SBAR(); GAPQ(C0=__builtin_amdgcn_mfma_f32_32x32x16_bf16(kf[6],qr[3],C0,0,0,0)); \
    VRD(3); SBAR(); GAPQ(C1=__builtin_amdgcn_mfma_f32_32x32x16_bf16(kf[7],qr[3],C1,0,0,0)); \
    if(GK){DMA_K((t)+3,sl_cur);} if(GV){DMA_V((t)+2);} \
    CMASK(C0,C1,t); \
    { float a=MX3(C0[0],C0[1],C1[0]),b=MX3(C0[2],C0[3],C1[1]); a=MX3(a,C1[2],C1[3]); \
      _Pragma("unroll") for(int r=4;r<16;r+=4){a=MX3(a,C0[r],C0[r+1]);b=MX3(b,C0[r+2],C0[r+3]);a=MX3(a,C1[r],C1[r+1]);b=MX3(b,C1[r+2],C1[r+3]);} \
      float rm=__builtin_fmaxf(a,b); { auto rr=__builtin_amdgcn_permlane32_swap(__float_as_uint(rm),__float_as_uint(rm),false,false); rm=__builtin_fmaxf(__uint_as_float(rr[0]),__uint_as_float(rr[1])); } \
      resc=false; \
      if(__builtin_expect(__any(rm>(float)THRL),0)){ const float dl=__builtin_fmaxf(rm,0.f); mhat+=dl; \
        _Pragma("unroll") for(int r=0;r<16;++r){C0[r]-=dl;C1[r]-=dl;} \
        _Pragma("unroll") for(int r=0;r<16;++r)negm[r]=-mhat; asm volatile("":"+v"(negm)); \
        const float f=__builtin_amdgcn_exp2f(-dl); l_reg*=f; if(hi==0)wsf[r32]=f; resc=true; } } \
    SBAR(); float sacc=0.f; \
    GAPB(PVM(0),  C0,0,  VRD(4)); \
    GAPB(PVM(1),  C0,2,  VRD(5)); \
    GAPB(PVM(2),  C0,4,  VRD(6)); \
    GAPB(PVM(3),  C0,6,  VRD(7)); \
    GAPB(PVM(4),  C0,8,  VRD(8);  pw0[0]=PKW(C0,0); pw0[1]=PKW(C0,2); PIN(pw0)); \
    GAPB(PVM(5),  C0,10, VRD(9);  pw0[2]=PKW(C0,4); pw0[3]=PKW(C0,6); PIN(pw0)); \
    GAPB(PVM(6),  C0,12, VRD(10)); \
    GAPB(PVM(7),  C0,14, VRD(11)); \
    GAPB(PVM(8),  C1,0,  VRD(12); pw1[0]=PKW(C0,8);  pw1[1]=PKW(C0,10); PIN(pw1)); \
    GAPB(PVM(9),  C1,2,  VRD(13); pw1[2]=PKW(C0,12); pw1[3]=PKW(C0,14); PIN(pw1)); \
    GAPB(PVM(10), C1,4,  VRD(14); KRD(GL,0)); \
    GAPB(PVM(11), C1,6,  VRD(15); KRD(GL,1)); \
    GAPB(PVM(12), C1,8,  KRD(GL,2); pw2[0]=PKW(C1,0); pw2[1]=PKW(C1,2); PIN(pw2)); \
    GAPB(PVM(13), C1,10, KRD(GL,3); pw2[2]=PKW(C1,4); pw2[3]=PKW(C1,6); PIN(pw2)); \
    GAPB(PVM(14), C1,12, (void)0); \
    GAPB(PVM(15), C1,14, (void)0); \
    pw3=(u32x4){PKW(C1,8),PKW(C1,10),PKW(C1,12),PKW(C1,14)}; l_reg+=sacc; \
    }while(0)
  #define PAFJ(j) PAFJ_((j)>>2)
  #define PAFJ_(k) ((k)==0?PAF(0):(k)==1?PAF(1):(k)==2?PAF(2):PAF(3))
  int t=1;
  #undef CMASK
  #define CMASK(P0,P1,t) do{}while(0)
  for(;t+7<NT;t+=2){
    STEP(pA0,pA1,t,true,true,true,0);     WAIT_BAR(5); RESC(); ROT();
    STEP(pA0,pA1,t+1,true,true,true,0);   WAIT_BAR(5); RESC(); ROT();
  }
  #undef CMASK
  #define CMASK(P0,P1,t) do{int jb_=(t)-(NT-4); if(jb_>=0)cmask(P0,P1,jb_,qrel,hi);}while(0)
  #define ENDW(tt) do{ if((tt)+3<NT){WAIT_BAR(5);} else if((tt)+2<NT){WAIT_BAR(4);} else {WAIT_BAR(0);} }while(0)
  for(;t+1<NT;t+=2){
    STEP(pA0,pA1,t,(t+3<NT),(t+2<NT),(t+1<NT),1);       ENDW(t);   RESC(); ROT();
    STEP(pA0,pA1,t+1,(t+4<NT),(t+3<NT),(t+2<NT),1);     ENDW(t+1); RESC(); ROT();
  }
  STEP(pA0,pA1,NT-1,false,false,false,1); RESC();
  { SBAR(); pv(o,vb0+VSL(NT-1),PAF(0),PAF(1),PAF(2),PAF(3)); }
  #undef PKW
  #undef PAF
  #undef VFR
  #undef PIN
  #undef MX3
  #undef GAPQ
  #undef PVM
  #undef PAFJ
  #undef PAFJ_
  #undef GAPB
  #undef EX
  #undef VRD
  #undef KRD
  #undef STEP
  #undef ENDW
  {auto rr=__builtin_amdgcn_permlane32_swap(__float_as_uint(l_reg),__float_as_uint(l_reg),false,false);l_reg=__uint_as_float(rr[0])+__uint_as_float(rr[1]);}
  if(hi==0)wsf[32+r32]=l_reg;asm volatile("s_waitcnt lgkmcnt(0)":::"memory");
  float rli[16];
  #pragma unroll
  for(int r=0;r<16;++r)rli[r]=__builtin_amdgcn_rcpf(wsf[32+crow(r,hi)]);
  bf16*Ow=O+(rowbase+q0+wid*QBLK)*OPITCH+ho*D;
  { bf16*stg=(bf16*)(shm+LDS_OST)+wid*2048;
    #pragma unroll
    for(int ps=0;ps<2;++ps){
      #pragma unroll
      for(int r=0;r<16;++r){const int orow=crow(r,hi);
        #pragma unroll
        for(int d0=0;d0<2;++d0)stg[orow*64+d0*32+r32]=__float2bfloat16(o[2*ps+d0][r]*rli[r]);}
      asm volatile("s_waitcnt lgkmcnt(0)":::"memory");
      #pragma unroll
      for(int i=0;i<4;++i){const int row=i*8+(lane>>3),ch=lane&7; const u32x4 v=*(const u32x4*)(stg+row*64+ch*8); ATTN_STORE16(Ow+(long)row*OPITCH+ps*64+ch*8,v);}
      asm volatile("s_waitcnt lgkmcnt(0)":::"memory"); } }
  asm volatile("s_waitcnt lgkmcnt(0)\n\ts_barrier":::"memory");
  #undef DMA_K
  #undef DMA_V
  #undef VSL
  #undef CMASK
  #undef START
  #undef RESC
  #undef ROT
}
constexpr int ATTN_LDS_BYTES=LDS_BYTES;
constexpr int BTAB_OFF=126976;
struct AttnTensors { const bf16* Q; const bf16* K; const bf16* V; bf16* O; };
struct AttnCombine { float lam, lam_init; const float* gain; bf16* ab; };
__device__ __forceinline__ void combine_block(const AttnCombine&C,const bf16*O,int b,int h,int qb){
  typedef unsigned u32x4c __attribute__((ext_vector_type(4)));
  int tid_=threadIdx.x; asm volatile("":"+v"(tid_)); const int lane=tid_&63; const int wid=__builtin_amdgcn_readfirstlane(tid_>>6);
  const int e0=(lane&7)*16; const long row0=(long)b*SEQ+qb*QB+wid*QBLK+(lane>>3);
  asm volatile("s_waitcnt vmcnt(0)":::"memory");
  u32x4c a0[4],a1[4],b0[4],b1[4];
  #pragma unroll
  for(int it=0;it<4;++it){ const bf16*p=O+(row0+8*it)*OPITCH+h*256+e0;
    a0[it]=*(const u32x4c*)p; a1[it]=*(const u32x4c*)(p+8); b0[it]=*(const u32x4c*)(p+128); b1[it]=*(const u32x4c*)(p+136); }
  float g[16];
  #pragma unroll
  for(int i=0;i<16;++i)g[i]=C.gain[e0+i];
  #pragma unroll
  for(int it=0;it<4;++it){ float o[16]; float ss=0.f;
    #pragma unroll
    for(int i=0;i<4;++i){
      o[2*i]=__uint_as_float(a0[it][i]<<16)-C.lam*__uint_as_float(b0[it][i]<<16); o[2*i+1]=__uint_as_float(a0[it][i]&0xffff0000u)-C.lam*__uint_as_float(b0[it][i]&0xffff0000u);
      o[8+2*i]=__uint_as_float(a1[it][i]<<16)-C.lam*__uint_as_float(b1[it][i]<<16); o[8+2*i+1]=__uint_as_float(a1[it][i]&0xffff0000u)-C.lam*__uint_as_float(b1[it][i]&0xffff0000u); }
    #pragma unroll
    for(int i=0;i<16;++i)ss+=o[i]*o[i];
    ss+=__shfl_xor(ss,1); ss+=__shfl_xor(ss,2); ss+=__shfl_xor(ss,4);
    const float r=__builtin_amdgcn_rsqf(ss*(1.0f/128.0f)+1e-6f)*(1.0f-C.lam_init);
    u32x4c w0,w1;
    #pragma unroll
    for(int i=0;i<4;++i){ w0[i]=cvtpk_s(o[2*i]*r*g[2*i],o[2*i+1]*r*g[2*i+1]); w1[i]=cvtpk_s(o[8+2*i]*r*g[8+2*i],o[8+2*i+1]*r*g[8+2*i+1]); }
    bf16*q=C.ab+(row0+8*it)*1024+h*128+e0; *(u32x4c*)q=w0; *(u32x4c*)(q+8)=w1; }
}
template<int THRL=8> __device__ __forceinline__ void attn_phase(char*lds,const AttnTensors&T,int vcu,int G,const float*btab_g,const AttnCombine&C){
  float*bt=(float*)(lds+BTAB_OFF); const lds_fptr bt3=(lds_fptr)(lds_cptr)lds+BTAB_OFF/4;
  for(int c=vcu;c<256;c+=G){
    const int b=c>>5,h=(c>>2)&7,qt=c&3;
    for(int i=threadIdx.x;i<768;i+=512){const int d=i-256; bt[i]=(d>=0&&d<128)?btab_g[h*128+d]:0.f;}
    __syncthreads();
    #pragma unroll 1
    for(int qi=0;qi<4;++qi){ const int qb=(qi>>1)?qt:7-qt, m=qi&1;
      attn_unit<THRL>(b,2*h+m,2*h,4*h+2*m,qb,T.Q,T.K,T.V,T.O,lds,bt3);
      if(m)combine_block(C,T.O,b,h,qb); }
    __syncthreads();
  }
}
#undef SBAR
#undef WAIT_BAR
}
#define GAS __attribute__((address_space(1)))
#define LAS __attribute__((address_space(3)))
typedef unsigned short bf16;
typedef unsigned v4u __attribute__((ext_vector_type(4)));
typedef float f32x4 __attribute__((ext_vector_type(4)));
typedef short bf16x8 __attribute__((ext_vector_type(8)));
typedef GAS unsigned gu32;
typedef GAS unsigned long long gu64;
#define RLX_AGENT __ATOMIC_RELAXED, __HIP_MEMORY_SCOPE_AGENT
#define LDS_WAIT() asm volatile("s_waitcnt lgkmcnt(0)" ::: "memory")
#define VM_WAIT() asm volatile("s_waitcnt vmcnt(0)" ::: "memory")
__device__ __forceinline__ unsigned long long rt() { return __builtin_amdgcn_s_memrealtime(); }
__device__ __forceinline__ unsigned f2bf(float f) { unsigned u = __builtin_bit_cast(unsigned, f); return (u + 0x7fffu + ((u >> 16) & 1u)) >> 16; }
__device__ __forceinline__ unsigned pk2(float lo, float hi) { return f2bf(lo) | (f2bf(hi) << 16); }

#define XB_TMO      128
#define XB_XCNT(j)  (256  + 64 * (j))
#define XB_XSUB(j)  (1280 + 64 * (j))
#define XB_XGEN(j)  (2304 + 64 * (j))
#define XB_TOP      3328
#define XB_TOPGEN   3392
#define XCD_BAR_WORDS 3456
#define XB_SPIN_CAP (1u << 18)

__device__ __forceinline__ unsigned xb_ld(unsigned* p)              { return __hip_atomic_load(p, __ATOMIC_RELAXED, __HIP_MEMORY_SCOPE_AGENT); }
__device__ __forceinline__ unsigned xb_add(unsigned* p, unsigned v) { return __hip_atomic_fetch_add(p, v, __ATOMIC_RELAXED, __HIP_MEMORY_SCOPE_AGENT); }
__device__ __forceinline__ unsigned xb_xcc_id() { return (unsigned)__builtin_amdgcn_s_getreg((3 << 11) | 20) & 0xFu; }
#define XB_SPIN(cond, bar) do { unsigned _sp = 0; while (cond) { __builtin_amdgcn_s_sleep(1); \
    if ((++_sp & 255u) == 0u) { if (xb_ld(&(bar)[XB_TMO])) break; if (_sp > XB_SPIN_CAP) { atomicAdd(&(bar)[XB_TMO], 1u); break; } } } } while (0)

struct XcdBarrier {
    unsigned* bar; unsigned x;
    volatile LAS unsigned* st;
};

__device__ __forceinline__ XcdBarrier xcd_barrier_post(unsigned* bar, volatile LAS unsigned* st) {
    XcdBarrier b; b.bar = bar; b.x = xb_xcc_id(); b.st = st;
    if (threadIdx.x == 0) (void)xb_add(&bar[XB_XCNT(b.x)], 1u);
    return b;
}
__device__ __forceinline__ void xcd_barrier_complete(unsigned* bar, unsigned x, unsigned& nloc, unsigned& nx) {
    const unsigned G = gridDim.x * gridDim.y * gridDim.z;
    unsigned sum, cnt, mine, sp = 0u;
    for (;;) {
        sum = 0u; cnt = 0u; mine = 0u;
#pragma unroll
        for (unsigned j = 0; j < 16; ++j) { const unsigned c = xb_ld(&bar[XB_XCNT(j)]); sum += c; cnt += (c > 0u) ? 1u : 0u; mine = (j == x) ? c : mine; }
        if (sum == G) break;
        __builtin_amdgcn_s_sleep(1);
        if ((++sp & 255u) == 0u) { if (xb_ld(&bar[XB_TMO])) break; if (sp > XB_SPIN_CAP) { atomicAdd(&bar[XB_TMO], 1u); break; } }
    }
    nloc = mine > 0u ? mine : 1u; nx = cnt > 0u ? cnt : 1u;
}

__device__ __forceinline__ void xcd_barrier(const XcdBarrier& b) {
    asm volatile("s_waitcnt vmcnt(0)" ::: "memory");
    __syncthreads();
    if (threadIdx.x == 0) {
        unsigned* bar = b.bar; unsigned bx_ = b.x; asm volatile("" : "+s"(bar), "+s"(bx_));
        __builtin_amdgcn_s_waitcnt(0);
        unsigned nloc = b.st[0], nx = b.st[1];
        if (nloc == 0u) { xcd_barrier_complete(bar, bx_, nloc, nx); b.st[0] = nloc; b.st[1] = nx; }
        asm volatile("buffer_inv sc1" ::: "memory");
        const unsigned old = xb_add(&bar[XB_XSUB(bx_)], 1u);
        const unsigned gen = old / nloc;
        if (old + 1u == (gen + 1u) * nloc) {
            __builtin_amdgcn_fence(__ATOMIC_RELEASE, "agent");
            asm volatile("s_waitcnt vmcnt(0)" ::: "memory");
            const unsigned og = xb_add(&bar[XB_TOP], 1u);
            const unsigned tg = og / nx;
            if (og + 1u == (tg + 1u) * nx) xb_add(&bar[XB_TOPGEN], 1u);
            else XB_SPIN(xb_ld(&bar[XB_TOPGEN]) == tg, bar);
            asm volatile("" ::: "memory");
            xb_add(&bar[XB_XGEN(bx_)], 1u);
            asm volatile("s_waitcnt vmcnt(0)" ::: "memory");
        } else {
            XB_SPIN(xb_ld(&bar[XB_XGEN(bx_)]) == gen, bar);
            asm volatile("" ::: "memory");
            asm volatile("s_waitcnt vmcnt(0)" ::: "memory");
        }
    }
    __syncthreads();
}

struct Frame {
    LAS unsigned char* lds; volatile LAS unsigned* MISC; gu32* ctl;
    int tid, lane, wave, vcu, G;
    float* out; unsigned char* ws;
};
struct Args { const float* in[25]; float* out; unsigned char* ws; int ph_lo, ph_hi, li, pad; };
__device__ __forceinline__ const float* ldin(const Args& a, int k) { int z; asm volatile("s_mov_b32 %0, 0" : "=s"(z)); return a.in[k + z]; }
#define IN(k) ldin(args, (k))
__device__ __forceinline__ float wave_sum(float v) {
#pragma unroll
    for (int o = 1; o < 64; o <<= 1) v += __shfl_xor(v, o);
    return v;
}
__device__ __forceinline__ float wave_max(float v) {
#pragma unroll
    for (int o = 1; o < 64; o <<= 1) v = fmaxf(v, __shfl_xor(v, o));
    return v;
}
__device__ __forceinline__ float wave_total(float v) {
    int x = __builtin_bit_cast(int, v);
#define DPPADD(ctrl, rm, bc) x = __builtin_bit_cast(int, __builtin_bit_cast(float, x) + __builtin_bit_cast(float, __builtin_amdgcn_update_dpp(0, x, ctrl, rm, 0xF, bc)))
    DPPADD(0xB1, 0xF, true); DPPADD(0x4E, 0xF, true); DPPADD(0x141, 0xF, true); DPPADD(0x140, 0xF, true); DPPADD(0x142, 0xA, false); DPPADD(0x143, 0xC, false);
#undef DPPADD
    return __builtin_bit_cast(float, __builtin_amdgcn_readlane(x, 63));
}
__device__ __forceinline__ float bf_lo(unsigned w) { return __uint_as_float(w << 16); }
__device__ __forceinline__ float bf_hi(unsigned w) { return __uint_as_float(w & 0xffff0000u); }
__device__ __forceinline__ float gelu_tanh_f(float x) { const float y = 0.7978845608028654f * (x + 0.044715f * x * x * x); return x * __builtin_amdgcn_rcpf(1.0f + __builtin_amdgcn_exp2f(-2.0f * LOG2E * y)); }

__device__ __forceinline__ void p0_transpose_item(const float* W, int Nsrc, int n0, const float* gain, bf16* WT, int dst_row0, int kb, LAS float* scr, int lane) {
    const int k0 = 64 * kb;
    f32x4 wv[8];
#pragma unroll
    for (int i = 0; i < 8; ++i) wv[i] = *(const GAS f32x4*)(W + (size_t)(k0 + 8 * i + (lane >> 3)) * Nsrc + n0 + 4 * (lane & 7));
#pragma unroll
    for (int i = 0; i < 8; ++i) { const int kk = 8 * i + (lane >> 3); const float g = gain ? gain[k0 + kk] : 1.0f; LAS float* d = scr + kk * 33 + 4 * (lane & 7);
        d[0] = wv[i][0] * g; d[1] = wv[i][1] * g; d[2] = wv[i][2] * g; d[3] = wv[i][3] * g; }
    LDS_WAIT(); asm volatile("" ::: "memory");
    const int c = lane & 7;
#pragma unroll
    for (int j = 0; j < 4; ++j) { const int n = (lane >> 3) + 8 * j; const LAS float* s = scr + (8 * c) * 33 + n;
        v4u o; o.x = pk2(s[0 * 33], s[1 * 33]); o.y = pk2(s[2 * 33], s[3 * 33]); o.z = pk2(s[4 * 33], s[5 * 33]); o.w = pk2(s[6 * 33], s[7 * 33]);
        *(GAS v4u*)(WT + (size_t)(dst_row0 + n) * 1024 + k0 + 8 * c) = o; }
    LDS_WAIT(); asm volatile("" ::: "memory");
}
__device__ __forceinline__ int p0_src_col(int type, int dst_nb) {
    const int tile = dst_nb >> 3, g = dst_nb & 7, bj = g >> 2, wc = g & 3;
    if (type == 1) return tile * 256 + (2 * wc + bj) * 32;
    if (type == 2 && tile >= 4) return (bj ? 2048 : 1024) + 128 * (tile - 4) + 32 * wc;
    return 32 * dst_nb;
}
__device__ __forceinline__ int rel_bucket(int n) {
    if (n < 16) return n;
    const int large = 16 + (int)(logf((float)n / 16.0f) / 2.0794415416798357f * 16.0f);
    return large < 31 ? large : 31;
}
__device__ __forceinline__ void quant_row_store(unsigned char* ws, int tab, int rr, const f32x4 (&v)[4], int lane) {
    float mx = 0.f;
#pragma unroll
    for (int i = 0; i < 4; ++i) mx = fmaxf(mx, fmaxf(fmaxf(fabsf(v[i][0]), fabsf(v[i][1])), fmaxf(fabsf(v[i][2]), fabsf(v[i][3]))));
    mx = wave_max(mx);
    const bool f4 = tab == 0 ? UF4 : VF4; const float top = f4 ? 6.0f : 440.0f;
    const float sc = mx > 0.f ? top / mx : 1.0f, isc = mx > 0.f ? mx / top : 1.0f;
    if (f4) { unsigned w0 = 0u, w1 = 0u;
        w0 = __builtin_amdgcn_cvt_scalef32_pk_fp4_f32(w0, v[0][0] * sc, v[0][1] * sc, 1.0f, 0); w0 = __builtin_amdgcn_cvt_scalef32_pk_fp4_f32(w0, v[0][2] * sc, v[0][3] * sc, 1.0f, 1);
        w0 = __builtin_amdgcn_cvt_scalef32_pk_fp4_f32(w0, v[1][0] * sc, v[1][1] * sc, 1.0f, 2); w0 = __builtin_amdgcn_cvt_scalef32_pk_fp4_f32(w0, v[1][2] * sc, v[1][3] * sc, 1.0f, 3);
        w1 = __builtin_amdgcn_cvt_scalef32_pk_fp4_f32(w1, v[2][0] * sc, v[2][1] * sc, 1.0f, 0); w1 = __builtin_amdgcn_cvt_scalef32_pk_fp4_f32(w1, v[2][2] * sc, v[2][3] * sc, 1.0f, 1);
        w1 = __builtin_amdgcn_cvt_scalef32_pk_fp4_f32(w1, v[3][0] * sc, v[3][1] * sc, 1.0f, 2); w1 = __builtin_amdgcn_cvt_scalef32_pk_fp4_f32(w1, v[3][2] * sc, v[3][3] * sc, 1.0f, 3);
        *(GAS v2u*)(ws + (tab == 0 ? WS_U8 : WS_V8) + (size_t)rr * 512 + 8 * lane) = (v2u){w0, w1};
    } else { v4u o;
#pragma unroll
        for (int i = 0; i < 4; ++i) { int w = 0; w = __builtin_amdgcn_cvt_pk_fp8_f32(v[i][0] * sc, v[i][1] * sc, w, false); w = __builtin_amdgcn_cvt_pk_fp8_f32(v[i][2] * sc, v[i][3] * sc, w, true); o[i] = (unsigned)w; }
        *(GAS v4u*)(ws + (tab == 0 ? WS_U8 : WS_V8) + (size_t)rr * 1024 + 16 * lane) = o; }
    if (lane == 0) ((float*)(ws + (tab == 0 ? WS_SU : WS_SV)))[rr] = isc;
}
__device__ __forceinline__ void p0_prologue(Frame& F, const Args& args) {
    LAS float* scr = (LAS float*)(F.lds + RING_OFF + F.wave * 16384);
    const int gw = F.vcu * NWAVES + F.wave, NGW = F.G * NWAVES;
    unsigned char* ws = F.ws;
    {
        constexpr int NB[12] = {96, 96, 32, 32, 96, 32, 64, 32, 64, 64, 64, 64};
        int base = 0;
#pragma unroll
        for (int mi = 0; mi < 12; ++mi) {
            const float* W; int Nsrc, type; const float* gain; bf16* dst;
            if (mi < 2)       { W = IN(4) + (size_t)mi * 1024 * 3072; Nsrc = 3072; type = 1; gain = IN(2) + (mi == 0 ? 0 : 3) * 1024; dst = (bf16*)(ws + WS_WQKV) + (size_t)mi * 3072 * 1024; }
            else if (mi < 4)  { W = IN(12) + (size_t)(mi - 2) * 1024 * 1024; Nsrc = 1024; type = 0; gain = nullptr; dst = (bf16*)(ws + WS_WO) + (size_t)(mi - 2) * 1024 * 1024; }
            else if (mi == 4) { W = IN(13); Nsrc = 3072; type = 2; gain = IN(2) + 1 * 1024; dst = (bf16*)(ws + WS_CIN); }
            else if (mi == 5) { W = IN(15); Nsrc = 1024; type = 0; gain = nullptr; dst = (bf16*)(ws + WS_COUT); }
            else if (mi == 6) { W = IN(16); Nsrc = 2048; type = 0; gain = IN(2) + 2 * 1024; dst = (bf16*)(ws + WS_SIN); }
            else if (mi == 7) { W = IN(20); Nsrc = 1024; type = 0; gain = nullptr; dst = (bf16*)(ws + WS_SOUT); }
            else              { W = IN(21) + (size_t)(mi - 8) * 1024 * 2048; Nsrc = 2048; type = 1; gain = IN(3) + (mi - 8) * 1024; dst = (bf16*)(ws + WS_PWQ) + (size_t)(mi - 8) * 2048 * 1024; }
            const int nitems = NB[mi] * 16;
            for (int it = gw; it < nitems; it += NGW) { const int nb = it >> 4, kb = it & 15; p0_transpose_item(W, Nsrc, p0_src_col(type, nb), gain, dst, 32 * nb, kb, scr, F.lane); }
            base += nitems;
        }
        (void)base;
    }
    const int gt = F.vcu * (NWAVES * 64) + F.tid, NGT = F.G * NWAVES * 64;
    { const float* kin = IN(22); bf16* kout = (bf16*)(ws + WS_PKEY);
      for (int i = gt; i < 4 * 8 * 2 * 128 * 128 / 8; i += NGT) { const f32x4 a = *(const GAS f32x4*)(kin + (size_t)i * 8), b = *(const GAS f32x4*)(kin + (size_t)i * 8 + 4);
          v4u o; o.x = pk2(a[0], a[1]); o.y = pk2(a[2], a[3]); o.z = pk2(b[0], b[1]); o.w = pk2(b[2], b[3]); *(GAS v4u*)(kout + (size_t)i * 8) = o; }
      const float* win = IN(18); bf16* wout = (bf16*)(ws + WS_SWS);
      for (int i = gt; i < 8 * 128 * 128; i += NGT) { const int s = i & 127, t = (i >> 7) & 127; wout[i] = (bf16)f2bf(s <= t ? win[i] : 0.0f); }
      float* bt = (float*)(ws + WS_BTAB); const float* rb = IN(1);
      for (int i = gt; i < 8 * 128; i += NGT) { const int h = i >> 7, d = i & 127; bt[i] = (rb[rel_bucket(d) * 8 + h] - rb[31 * 8 + h]) * LOG2E; }
    }
    for (int r0 = 4 * gw; r0 < 2 * DEPTH * NEXP; r0 += 4 * NGW) {
        const int tab = r0 / (DEPTH * NEXP), rr0 = r0 % (DEPTH * NEXP);
        const float* src = (tab == 0 ? IN(23) : IN(24)) + (size_t)rr0 * 1024 + 4 * F.lane;
        f32x4 v[4][4];
#pragma unroll
        for (int q = 0; q < 4; ++q)
#pragma unroll
            for (int i = 0; i < 4; ++i) v[q][i] = __builtin_nontemporal_load((const GAS f32x4*)(src + (size_t)q * 1024 + 256 * i));
#pragma unroll
        for (int q = 0; q < 4; ++q) quant_row_store(ws, tab, rr0 + q, v[q], F.lane);
    }
    for (int row0 = 4 * gw; row0 < T; row0 += 4 * NGW) {
        const float* src = IN(0) + (size_t)row0 * 1024 + 4 * F.lane; bf16* hb = (bf16*)(ws + WS_HBF) + (size_t)row0 * 1024 + 4 * F.lane;
        f32x4 v[4][4];
#pragma unroll
        for (int q = 0; q < 4; ++q)
#pragma unroll
            for (int i = 0; i < 4; ++i) v[q][i] = __builtin_nontemporal_load((const GAS f32x4*)(src + (size_t)q * 1024 + 256 * i));
#pragma unroll
        for (int q = 0; q < 4; ++q) { float ss = 0.f;
#pragma unroll
            for (int i = 0; i < 4; ++i) { const f32x4 x = v[q][i]; ss += (x[0] * x[0] + x[1] * x[1]) + (x[2] * x[2] + x[3] * x[3]);
                typedef unsigned u32x2 __attribute__((ext_vector_type(2))); u32x2 pw; pw.x = pk2(x[0], x[1]); pw.y = pk2(x[2], x[3]); *(GAS u32x2*)(hb + (size_t)q * 1024 + 256 * i) = pw; }
            ss = wave_sum(ss);
            if (F.lane < 16) ((float*)(ws + WS_PART))[(size_t)(row0 + q) * 16 + F.lane] = F.lane == 0 ? ss : 0.f; }
    }
}
__device__ __forceinline__ void phase_attn_combine(Frame& F, const Args& args, int j, float lam_init) {
    const int gw = F.vcu * NWAVES + F.wave, NGW = F.G * NWAVES, lane = F.lane;
    const float* lq1 = IN(7) + j * 64; const float* lk1 = IN(8) + j * 64; const float* lq2 = IN(9) + j * 64; const float* lk2 = IN(10) + j * 64;
    const float lam = expf(wave_sum(lq1[lane] * lk1[lane])) - expf(wave_sum(lq2[lane] * lk2[lane])) + lam_init;
    const int h8 = lane >> 3, e0 = (lane & 7) * 16;
    const float* sg = IN(11) + j * 128 + e0;
    f32x4 g[4];
#pragma unroll
    for (int i = 0; i < 4; ++i) g[i] = *(const GAS f32x4*)(sg + 4 * i);
    const bf16* o2 = (const bf16*)(F.ws + WS_O2); bf16* ab = (bf16*)(F.ws + WS_AB);
    for (int row = gw; row < T; row += NGW) {
        const bf16* p = o2 + (size_t)row * 2048 + h8 * 256 + e0;
        const v4u a0 = *(const GAS v4u*)p, a1 = *(const GAS v4u*)(p + 8), b0 = *(const GAS v4u*)(p + 128), b1 = *(const GAS v4u*)(p + 136);
        float o[16]; float ss = 0.f;
#pragma unroll
        for (int i = 0; i < 4; ++i) {
            o[2 * i] = bf_lo(a0[i]) - lam * bf_lo(b0[i]); o[2 * i + 1] = bf_hi(a0[i]) - lam * bf_hi(b0[i]);
            o[8 + 2 * i] = bf_lo(a1[i]) - lam * bf_lo(b1[i]); o[8 + 2 * i + 1] = bf_hi(a1[i]) - lam * bf_hi(b1[i]); }
#pragma unroll
        for (int i = 0; i < 16; ++i) ss += o[i] * o[i];
        ss += __shfl_xor(ss, 1); ss += __shfl_xor(ss, 2); ss += __shfl_xor(ss, 4);
        const float r = __builtin_amdgcn_rsqf(ss * (1.0f / 128.0f) + EPS) * (1.0f - lam_init);
        v4u w0, w1;
#pragma unroll
        for (int i = 0; i < 4; ++i) { w0[i] = pk2(o[2 * i] * r * g[i >> 1][(2 * i) & 3], o[2 * i + 1] * r * g[i >> 1][(2 * i + 1) & 3]);
                                      w1[i] = pk2(o[8 + 2 * i] * r * g[2 + (i >> 1)][(2 * i) & 3], o[8 + 2 * i + 1] * r * g[2 + (i >> 1)][(2 * i + 1) & 3]); }
        bf16* q = ab + (size_t)row * 1024 + h8 * 128 + e0; *(GAS v4u*)q = w0; *(GAS v4u*)(q + 8) = w1;
    }
}
__device__ __forceinline__ void phase_conv_mix(Frame& F, const Args& args) {
    const int gw = F.vcu * NWAVES + F.wave, NGW = F.G * NWAVES, d0 = 16 * F.lane;
    const bf16* bc = (const bf16*)(F.ws + WS_QB); const bf16* z = (const bf16*)(F.ws + WS_KB); bf16* ab = (bf16*)(F.ws + WS_AB);
    const float* cw = IN(14);
    float w0[16], w1[16], w2[16];
#pragma unroll
    for (int i = 0; i < 16; ++i) { w0[i] = cw[d0 + i]; w1[i] = cw[1024 + d0 + i]; w2[i] = cw[2048 + d0 + i]; }
    for (int row0 = 4 * gw; row0 < T; row0 += 4 * NGW) {
        const int t0 = row0 & (SEQ - 1);
        const size_t off0 = (size_t)row0 * 1024 + d0;
        v4u b[4][2], zz[6][2];
#pragma unroll
        for (int q = 0; q < 4; ++q)
#pragma unroll
            for (int hh = 0; hh < 2; ++hh) b[q][hh] = *(const GAS v4u*)(bc + off0 + (size_t)q * 1024 + 8 * hh);
#pragma unroll
        for (int q = 0; q < 6; ++q)
#pragma unroll
            for (int hh = 0; hh < 2; ++hh) zz[q][hh] = (q >= 2 || t0 >= 2) ? *(const GAS v4u*)(z + off0 + (size_t)q * 1024 - 2048 + 8 * hh) : (v4u){0u, 0u, 0u, 0u};
#pragma unroll
        for (int q = 0; q < 4; ++q) {
            v4u o[2];
#pragma unroll
            for (int hh = 0; hh < 2; ++hh)
#pragma unroll
                for (int i = 0; i < 4; ++i) { const int e = 8 * hh + 2 * i;
                    const float lo = bf_lo(b[q][hh][i]) * (w0[e] * bf_lo(zz[q][hh][i]) + w1[e] * bf_lo(zz[q + 1][hh][i]) + w2[e] * bf_lo(zz[q + 2][hh][i]));
                    const float hi = bf_hi(b[q][hh][i]) * (w0[e + 1] * bf_hi(zz[q][hh][i]) + w1[e + 1] * bf_hi(zz[q + 1][hh][i]) + w2[e + 1] * bf_hi(zz[q + 2][hh][i]));
                    o[hh][i] = pk2(lo, hi); }
            *(GAS v4u*)(ab + off0 + (size_t)q * 1024) = o[0]; *(GAS v4u*)(ab + off0 + (size_t)q * 1024 + 8) = o[1];
        }
    }
}
constexpr int SG_STRIDE = 288;
__device__ __forceinline__ void phase_sgu_spatial(Frame& F, const Args& args) {
    const int tid = F.tid, wid = F.wave, lane = F.lane, fr = lane & 15, fq = lane >> 4, wr = wid >> 2, wc = wid & 3;
    const bf16* zg = (const bf16*)(F.ws + WS_QB); const bf16* wsb = (const bf16*)(F.ws + WS_SWS); const float* part2 = (const float*)(F.ws + WS_PART2);
    bf16* ab = (bf16*)(F.ws + WS_AB); const float* vgain = IN(17); const float* bs = IN(19);
    LAS unsigned char* Wt = F.lds; LAS unsigned char* Vt = F.lds + 128 * SG_STRIDE;
    for (int unit = F.vcu; unit < 1024; unit += F.G) {
        const int g = unit & 7, chunk = unit >> 3; const int row0 = chunk * 128;
#pragma unroll
        for (int i = 0; i < 4; ++i) { const int q = tid + 512 * i, t = q >> 4, sc = q & 15;
            *(LAS v4u*)(Wt + t * SG_STRIDE + sc * 16) = *(const GAS v4u*)(wsb + ((size_t)g * 128 + t) * 128 + sc * 8); }
        { const int s = tid & 127; const float* pp = part2 + (size_t)(row0 + s) * 16;
          float sm = 0.f;
#pragma unroll
          for (int i = 0; i < 4; ++i) { const f32x4 pv = *(const GAS f32x4*)(pp + 4 * i); sm += (pv[0] + pv[1]) + (pv[2] + pv[3]); }
          const float rv = __builtin_amdgcn_rsqf(sm * (1.0f / 1024.0f) + EPS);
#pragma unroll
          for (int i = 0; i < 4; ++i) { const int cc = (tid >> 7) + 4 * i;
              const v4u x = *(const GAS v4u*)(zg + (size_t)(row0 + s) * 2048 + 1024 + g * 128 + cc * 8);
#pragma unroll
              for (int e = 0; e < 4; ++e) { *(LAS unsigned short*)(Vt + (cc * 8 + 2 * e) * SG_STRIDE + s * 2) = (unsigned short)f2bf(bf_lo(x[e]) * rv);
                                            *(LAS unsigned short*)(Vt + (cc * 8 + 2 * e + 1) * SG_STRIDE + s * 2) = (unsigned short)f2bf(bf_hi(x[e]) * rv); } } }
        LDS_WAIT(); __syncthreads();
        f32x4 acc[4][2];
#pragma unroll
        for (int m = 0; m < 4; ++m)
#pragma unroll
            for (int n = 0; n < 2; ++n) acc[m][n] = (f32x4){0.f, 0.f, 0.f, 0.f};
#pragma unroll
        for (int kk = 0; kk < 4; ++kk) {
            bf16x8 af[4], bfr[2];
#pragma unroll
            for (int m = 0; m < 4; ++m) af[m] = *(const LAS bf16x8*)(Wt + (64 * wr + 16 * m + fr) * SG_STRIDE + (32 * kk + 8 * fq) * 2);
#pragma unroll
            for (int n = 0; n < 2; ++n) bfr[n] = *(const LAS bf16x8*)(Vt + (32 * wc + 16 * n + fr) * SG_STRIDE + (32 * kk + 8 * fq) * 2);
#pragma unroll
            for (int m = 0; m < 4; ++m)
#pragma unroll
                for (int n = 0; n < 2; ++n) acc[m][n] = __builtin_amdgcn_mfma_f32_16x16x32_bf16(bfr[n], af[m], acc[m][n], 0, 0, 0);
        }
#pragma unroll
        for (int m = 0; m < 4; ++m) { const int tl = 64 * wr + 16 * m + fr; const int row = row0 + tl; const float bsv = bs[g * 128 + tl];
#pragma unroll
            for (int n = 0; n < 2; ++n) { const int c = g * 128 + 32 * wc + 16 * n + 4 * fq;
                typedef unsigned u32x2 __attribute__((ext_vector_type(2)));
                const u32x2 uu = *(const GAS u32x2*)(zg + (size_t)row * 2048 + c); const f32x4 gn = *(const GAS f32x4*)(vgain + c);
                u32x2 o; o.x = pk2(bf_lo(uu.x) * (acc[m][n][0] * gn[0] + bsv), bf_hi(uu.x) * (acc[m][n][1] * gn[1] + bsv));
                         o.y = pk2(bf_lo(uu.y) * (acc[m][n][2] * gn[2] + bsv), bf_hi(uu.y) * (acc[m][n][3] * gn[3] + bsv));
                *(GAS u32x2*)(ab + (size_t)row * 1024 + c) = o; } }
        LDS_WAIT(); __syncthreads();
    }
}
typedef float f32x2v __attribute__((ext_vector_type(2)));
template <bool F4> __device__ __forceinline__ v4u row_load(const unsigned char* tab, int e, unsigned lane) {
    if constexpr (F4) { const v2u t = *(const GAS v2u*)(tab + (size_t)(unsigned)e * 512 + 8u * lane); return (v4u){t.x, t.y, 0u, 0u}; }
    else return *(const GAS v4u*)(tab + (size_t)(unsigned)e * 1024 + 16u * lane);
}
__device__ __forceinline__ v4u row_load4(const unsigned char* tab, int& ivreg, int k, unsigned& lane8) {
    asm volatile("" : "+v"(ivreg));
    int e = __builtin_amdgcn_readlane(ivreg, k); asm volatile("" : "+s"(e));
    asm volatile("" : "+v"(lane8));
    const GAS unsigned char* rb = (const GAS unsigned char*)tab + ((size_t)(unsigned)e << 9);
    const v2u t = *(const GAS v2u*)(rb + lane8); return (v4u){t.x, t.y, 0u, 0u};
}
template <bool F4, int P> __device__ __forceinline__ f32x2v row_pair(const v4u& w) {
    if constexpr (F4) return __builtin_amdgcn_cvt_scalef32_pk_f32_fp4(w[P >> 2], 1.0f, P & 3);
    else return __builtin_amdgcn_cvt_pk_f32_fp8((int)w[P >> 1], (P & 1) != 0);
}
#define P8(X) X(0) X(1) X(2) X(3) X(4) X(5) X(6) X(7)
__device__ __forceinline__ float dpp_xor1(float v) { return __builtin_bit_cast(float, __builtin_amdgcn_update_dpp(0, __builtin_bit_cast(int, v), 0xB1, 0xF, 0xF, true)); }
__device__ __forceinline__ float dpp_xor2(float v) { return __builtin_bit_cast(float, __builtin_amdgcn_update_dpp(0, __builtin_bit_cast(int, v), 0x4E, 0xF, 0xF, true)); }
__device__ __forceinline__ float swz_xor4(float v) { return __builtin_bit_cast(float, __builtin_amdgcn_ds_swizzle(__builtin_bit_cast(int, v), 0x101F)); }
__device__ __forceinline__ float dpp_xor8(float v) { return __builtin_bit_cast(float, __builtin_amdgcn_update_dpp(0, __builtin_bit_cast(int, v), 0x128, 0xF, 0xF, true)); }
__device__ __forceinline__ float reduce16(const float (&pr)[16], int lane) {
    const bool b0 = (lane & 1) != 0, b1 = (lane & 2) != 0, b2 = (lane & 4) != 0, b3 = (lane & 8) != 0;
    float a[8], b[4], c[2];
#pragma unroll
    for (int i = 0; i < 8; ++i) { const float keep = b0 ? pr[2 * i + 1] : pr[2 * i], send = b0 ? pr[2 * i] : pr[2 * i + 1]; a[i] = keep + dpp_xor1(send); }
#pragma unroll
    for (int i = 0; i < 4; ++i) { const float keep = b1 ? a[2 * i + 1] : a[2 * i], send = b1 ? a[2 * i] : a[2 * i + 1]; b[i] = keep + dpp_xor2(send); }
#pragma unroll
    for (int i = 0; i < 2; ++i) { const float keep = b2 ? b[2 * i + 1] : b[2 * i], send = b2 ? b[2 * i] : b[2 * i + 1]; c[i] = keep + swz_xor4(send); }
    float v; { const float keep = b3 ? c[1] : c[0], send = b3 ? c[0] : c[1]; v = keep + dpp_xor8(send); }
    v += __shfl_xor(v, 16); v += __shfl_xor(v, 32);
    return v;
}
template <bool LAST>
__device__ __forceinline__ void phase_peer_expert(Frame& F, const Args& args, int layer, float psc) {
    const int gw = F.vcu * NWAVES + F.wave, NGW = F.G * NWAVES, lane = F.lane;
    const unsigned char* U8 = F.ws + WS_U8 + (size_t)layer * NEXP * URB; const unsigned char* V8 = F.ws + WS_V8 + (size_t)layer * NEXP * VRB;
    LAS float* su = (LAS float*)(F.lds); LAS float* sv = (LAS float*)(F.lds + NEXP * 4);
    {   const float* gsu = (const float*)(F.ws + WS_SU) + layer * NEXP; const float* gsv = (const float*)(F.ws + WS_SV) + layer * NEXP;
#pragma unroll
        for (int i = 0; i < NEXP / (512 * 4); ++i) { const int o = (i * 512 + F.tid) * 4;
            *(LAS f32x4*)(su + o) = *(const GAS f32x4*)(gsu + o); *(LAS f32x4*)(sv + o) = *(const GAS f32x4*)(gsv + o); }
        LDS_WAIT(); __syncthreads(); }
    const float* part = (const float*)(F.ws + WS_PART); float* partw = (float*)(F.ws + WS_PART);
    const int* idxp = (const int*)(F.ws + WS_IDX); const float* gatep = (const float*)(F.ws + WS_GATE);
    const float* gf = IN(3) + layer * 1024 + 4 * lane;
    constexpr bool conv_next = false;
    const float* cu_src = IN(23) + (size_t)(conv_next ? layer + 1 : layer) * NEXP * 1024 + 4 * lane; const float* cv_src = IN(24) + (size_t)(conv_next ? layer + 1 : layer) * NEXP * 1024 + 4 * lane;
    f32x4 gn[4];
#pragma unroll
    for (int i = 0; i < 4; ++i) gn[i] = *(const GAS f32x4*)(gf + 256 * i);
    constexpr int RD = 16;
    static_assert(UF4 && VF4, "row_load4 gathers fp4 rows");
    unsigned lane8 = 8u * (unsigned)lane;
#define ROWLD_S(s_) (((s_) < 128) ? row_load4(U8, iv[((s_) >> 6) & 1], (s_) & 63, lane8) : \
                     ((s_) < 256) ? row_load4(V8, iv[((s_) >> 6) & 1], (s_) & 63, lane8) : \
                                    row_load4(U8, iv_n[0], (s_) & 63, lane8))
#define PIN_VMEM() __builtin_amdgcn_sched_barrier(0x1 | 0x2 | 0x4 | 0x80 | 0x100 | 0x200)
    int t = gw;
    if (t >= T) return;
    typedef unsigned u32x2 __attribute__((ext_vector_type(2)));
    const bf16* hbase = (const bf16*)(F.ws + WS_HBF) + 4 * lane;
    int iv[2]; float gt[2]; u32x2 hv[4]; f32x4 pv;
#pragma unroll
    for (int hh = 0; hh < 2; ++hh) { iv[hh] = idxp[(size_t)t * 128 + 64 * hh + lane]; gt[hh] = gatep[(size_t)t * 128 + 64 * hh + lane]; }
#pragma unroll
    for (int i = 0; i < 4; ++i) hv[i] = *(const GAS u32x2*)(hbase + (size_t)t * 1024 + 256 * i);
    pv = *(const GAS f32x4*)(part + (size_t)t * 16 + 4 * (lane & 3));
    v4u buf[RD];
    { int iv_n[2] = {iv[0], iv[1]}; (void)iv_n;
#pragma unroll
      for (int j = 0; j < RD; ++j) buf[j] = ROWLD_S(j);
      PIN_VMEM(); }
    for (;;) {
        const int tn = t + NGW; const bool has_next = tn < T; const int tq = has_next ? tn : t;
        float* hrow = F.out + (size_t)t * 1024 + 4 * lane;
        int iv_n[2]; float gt_n[2]; u32x2 hv_n[4]; f32x4 pv_n;
#pragma unroll
        for (int hh = 0; hh < 2; ++hh) { iv_n[hh] = idxp[(size_t)tq * 128 + 64 * hh + lane]; gt_n[hh] = gatep[(size_t)tq * 128 + 64 * hh + lane]; }
#pragma unroll
        for (int i = 0; i < 4; ++i) hv_n[i] = *(const GAS u32x2*)(hbase + (size_t)tq * 1024 + 256 * i);
        pv_n = *(const GAS f32x4*)(part + (size_t)tq * 16 + 4 * (lane & 3));
        f32x4 cu[4], cv[4];
        if (conv_next) {
#pragma unroll
            for (int i = 0; i < 4; ++i) { cu[i] = __builtin_nontemporal_load((const GAS f32x4*)(cu_src + (size_t)t * 1024 + 256 * i)); cv[i] = __builtin_nontemporal_load((const GAS f32x4*)(cv_src + (size_t)t * 1024 + 256 * i)); }
        }
        float s_u[2], s_v[2];
#pragma unroll
        for (int hh = 0; hh < 2; ++hh) { s_u[hh] = su[iv[hh]]; s_v[hh] = sv[iv[hh]]; }
        PIN_VMEM();
        float rs; { float s = (pv[0] + pv[1]) + (pv[2] + pv[3]); s += __shfl_xor(s, 1); s += __shfl_xor(s, 2); rs = __builtin_amdgcn_rsqf(s * (1.0f / 1024.0f) + EPS); }
        f32x2v x2[8];
#pragma unroll
        for (int i = 0; i < 4; ++i) { x2[2 * i] = (f32x2v){bf_lo(hv[i].x) * rs * gn[i][0], bf_hi(hv[i].x) * rs * gn[i][1]}; x2[2 * i + 1] = (f32x2v){bf_lo(hv[i].y) * rs * gn[i][2], bf_hi(hv[i].y) * rs * gn[i][3]}; }
        float coef[2];
#pragma unroll
        for (int hh = 0; hh < 2; ++hh) {
            float actv = 0.f;
#pragma unroll
            for (int kb = 0; kb < 4; ++kb) {
                float pr[16];
#pragma unroll
                for (int kj = 0; kj < 16; ++kj) {
                    const int k = 16 * kb + kj, s = 64 * hh + k; const v4u w = buf[s % RD];
                    buf[s % RD] = ROWLD_S(s + RD);
                    PIN_VMEM();
                    f32x2v d2 = {0.f, 0.f};
#define DOTP(p) d2 += row_pair<UF4, p>(w) * x2[p];
                    P8(DOTP)
#undef DOTP
                    pr[kj] = d2.x + d2.y;
                }
                const float v = reduce16(pr, lane);
                actv = ((lane >> 4) == kb) ? v : actv;
            }
            coef[hh] = gelu_tanh_f(actv * s_u[hh]) * gt[hh] * s_v[hh] * psc;
        }
        f32x2v o2[8];
#pragma unroll
        for (int i = 0; i < 8; ++i) o2[i] = (f32x2v){0.f, 0.f};
#pragma unroll
        for (int hh = 0; hh < 2; ++hh) {
#pragma unroll
            for (int k = 0; k < 64; ++k) {
                const int s = 128 + 64 * hh + k; const v4u w = buf[s % RD];
                buf[s % RD] = ROWLD_S(s + RD);
                PIN_VMEM();
                const float c = __builtin_bit_cast(float, __builtin_amdgcn_readlane(__builtin_bit_cast(int, coef[hh]), k));
                const f32x2v c2 = {c, c};
#define ACCP(p) o2[p] += c2 * row_pair<VF4, p>(w);
                P8(ACCP)
#undef ACCP
            }
        }
        float ss = 0.f;
        bf16* hb = (bf16*)(F.ws + WS_HBF) + (size_t)t * 1024 + 4 * lane;
#pragma unroll
        for (int i = 0; i < 4; ++i) {
            const f32x4 nv = {bf_lo(hv[i].x) + o2[2 * i].x, bf_hi(hv[i].x) + o2[2 * i].y, bf_lo(hv[i].y) + o2[2 * i + 1].x, bf_hi(hv[i].y) + o2[2 * i + 1].y};
            ss += (nv[0] * nv[0] + nv[1] * nv[1]) + (nv[2] * nv[2] + nv[3] * nv[3]);
            if (LAST) *(GAS f32x4*)(hrow + 256 * i) = nv;
            else { asm volatile("global_store_dwordx2 %0, %1, off sc0 sc1\n\ts_nop 1" :: "v"(hb + 256 * i), "v"((u32x2){pk2(nv[0], nv[1]), pk2(nv[2], nv[3])}) : "memory"); } }
        ss = wave_sum(ss);
        if (lane < 16) partw[(size_t)t * 16 + lane] = lane == 0 ? ss : 0.f;
        if (conv_next) { quant_row_store(F.ws, 0, (layer + 1) * NEXP + t, cu, lane); quant_row_store(F.ws, 1, (layer + 1) * NEXP + t, cv, lane); }
        if (!has_next) break;
        t = tn;
#pragma unroll
        for (int hh = 0; hh < 2; ++hh) { iv[hh] = iv_n[hh]; gt[hh] = gt_n[hh]; }
#pragma unroll
        for (int i = 0; i < 4; ++i) hv[i] = hv_n[i];
        pv = pv_n;
    }
#undef ROWLD_S
#undef PIN_VMEM
}
#ifndef EN_P0
#define EN_P0 1
#endif
#ifndef EN_QKV
#define EN_QKV 1
#endif
#ifndef EN_ATTN
#define EN_ATTN 1
#endif
#ifndef EN_COMB
#define EN_COMB 1
#endif
#ifndef EN_OUT
#define EN_OUT 1
#endif
#ifndef EN_CIN
#define EN_CIN 1
#endif
#ifndef EN_CONV2
#define EN_CONV2 1
#endif
#ifndef EN_SIN
#define EN_SIN 1
#endif
#ifndef EN_SGU2
#define EN_SGU2 1
#endif
#ifndef EN_ROUTE
#define EN_ROUTE 1
#endif
#ifndef EN_EXP
#define EN_EXP 1
#endif
constexpr int N_PHASES = 1 + 6 * DEPTH;
__global__ void __launch_bounds__(NWAVES * 64, 2) mega_fwd(Args args) {
    extern __shared__ __attribute__((aligned(16))) unsigned char lds[];
    Frame F;
    F.lds = (LAS unsigned char*)lds; F.MISC = (volatile LAS unsigned*)(F.lds + MISC_OFF);
    F.tid = threadIdx.x; F.lane = F.tid & 63; F.wave = __builtin_amdgcn_readfirstlane(F.tid >> 6);
    F.G = gridDim.x; { const int bx = blockIdx.x; F.vcu = (F.G % 8 == 0) ? (bx % 8) * (F.G / 8) + bx / 8 : bx; }
    F.ws = args.ws; F.ctl = (gu32*)(args.ws + WS_CTL); F.out = args.out;
    if (F.tid < 128) ((LAS unsigned*)(F.lds + MISC_OFF))[F.tid] = 0u;
    __syncthreads();
    XcdBarrier bar = xcd_barrier_post((unsigned*)(F.ctl + CW_BAR) + args.li * XCD_BAR_WORDS, F.MISC + 8);
    bool first = true;
#ifndef PROBE_CLASS
#define PROBE_CLASS 0
#endif
#define PHASE_BEGIN(p, cls) if (args.ph_lo <= (p) && (p) < args.ph_hi) for (int rep_ = ((cls) == PROBE_CLASS ? 0 : 1); rep_ < 2; ++rep_) { if (!first) xcd_barrier(bar); first = false; \
    const float psc = rep_ ? 1.0f : (float)args.pad; (void)psc; \
    int t_ = threadIdx.x; asm volatile("" : "+v"(t_)); F.tid = t_; F.lane = t_ & 63; F.wave = __builtin_amdgcn_readfirstlane(t_ >> 6); \
    size_t z_ = 0; asm volatile("" : "+s"(z_)); unsigned char* ws = args.ws + z_; float* out_ = args.out + z_; F.ws = ws; F.out = out_; F.ctl = (gu32*)args.ws;
#define PHASE_END }
    PHASE_BEGIN(0, 1)
#if EN_P0
        p0_prologue(F, args);
#endif
    PHASE_END
#pragma unroll 1
    for (int layer = 0; layer < DEPTH; ++layer) {
        const int pb = 1 + 6 * layer, mix = layer % 3, j = layer / 3;
        if (mix == 0) {
            PHASE_BEGIN(pb + 0, 2)
#if EN_QKV
            {   pg8::Gemm g{(const pg8::bf16_t*)(ws + WS_HBF), (const pg8::bf16_t*)(ws + WS_WQKV) + (size_t)j * 3072 * 1024};
                pg8::StaticOrderT<3072> S; S.init(F.G, (int)blockIdx.x);
                pg8::EpiQKV E{ws, IN(5) + j * 64, IN(6) + j * 64};
                pg8::gemm_phase<pg8::EpiQKV, pg8::StaticOrderT<3072>, true, true>(F.lds + RING_OFF, g, S, E); }
#endif
            PHASE_END
            PHASE_BEGIN(pb + 1, 3)
#if EN_ATTN
            {   const attn_body::AttnTensors AT{(const attn_body::bf16*)(ws + WS_QB), (const attn_body::bf16*)(ws + WS_KB), (const attn_body::bf16*)(ws + WS_VB), (attn_body::bf16*)(ws + WS_O2)};
                const float lam_init = 0.8f - 0.6f * expf(-0.3f * (float)layer);
                const float* lq1 = IN(7) + j * 64; const float* lk1 = IN(8) + j * 64; const float* lq2 = IN(9) + j * 64; const float* lk2 = IN(10) + j * 64;
                const float lam = expf(wave_sum(lq1[F.lane] * lk1[F.lane])) - expf(wave_sum(lq2[F.lane] * lk2[F.lane])) + lam_init;
                const attn_body::AttnCombine AC{__builtin_bit_cast(float, __builtin_amdgcn_readfirstlane(__builtin_bit_cast(int, lam))), __builtin_bit_cast(float, __builtin_amdgcn_readfirstlane(__builtin_bit_cast(int, lam_init))), IN(11) + j * 128, (attn_body::bf16*)(ws + WS_AB)};
                attn_body::attn_phase<8>((char*)lds + RING_OFF, AT, F.vcu, F.G, (const float*)(ws + WS_BTAB), AC); }
#endif
            PHASE_END
        } else if (mix == 1) {
            PHASE_BEGIN(pb + 0, 2)
#if EN_CIN
            {   pg8::Gemm g{(const pg8::bf16_t*)(ws + WS_HBF), (const pg8::bf16_t*)(ws + WS_CIN)};
                pg8::StaticOrderT<3072> S; S.init(F.G, (int)blockIdx.x);
                pg8::EpiConvIn E{ws};
                pg8::gemm_phase<pg8::EpiConvIn, pg8::StaticOrderT<3072>, true, true>(F.lds + RING_OFF, g, S, E); }
#endif
            PHASE_END
            PHASE_BEGIN(pb + 1, 7)
#if EN_CONV2
                phase_conv_mix(F, args);
#endif
            PHASE_END
        } else {
            PHASE_BEGIN(pb + 0, 2)
#if EN_SIN
            {   pg8::Gemm g{(const pg8::bf16_t*)(ws + WS_HBF), (const pg8::bf16_t*)(ws + WS_SIN)};
                pg8::StaticOrderT<2048> S; S.init(F.G, (int)blockIdx.x);
                pg8::EpiSguIn E{ws};
                pg8::gemm_phase<pg8::EpiSguIn, pg8::StaticOrderT<2048>, true, true>(F.lds + RING_OFF, g, S, E); }
#endif
            PHASE_END
            PHASE_BEGIN(pb + 1, 7)
#if EN_SGU2
                phase_sgu_spatial(F, args);
#endif
            PHASE_END
        }
        PHASE_BEGIN(pb + 3, 4)
#if EN_OUT
        {   const size_t woff = mix == 0 ? WS_WO + (size_t)j * 1024 * 1024 * 2 : (mix == 1 ? WS_COUT : WS_SOUT);
            pg8::Gemm g{(const pg8::bf16_t*)(ws + WS_AB), (const pg8::bf16_t*)(ws + woff)};
            pg8::StaticOrderT<1024> S; S.init(F.G, (int)blockIdx.x);
            pg8::EpiResid E{ws, psc};
            pg8::gemm_phase<pg8::EpiResid, pg8::StaticOrderT<1024>, true, true>(F.lds + RING_OFF, g, S, E); }
#endif
        PHASE_END
        PHASE_BEGIN(pb + 4, 5)
#if EN_ROUTE
        {   pg8::Gemm g{(const pg8::bf16_t*)(ws + WS_HBF), (const pg8::bf16_t*)(ws + WS_PWQ) + (size_t)layer * 2048 * 1024};
            pg8::EpiRoute E{ws, layer, 0, pg8::Unit{}};
            pg8::OneUnit S; S.S.init(F.G, (int)blockIdx.x);
            pg8::Unit uu;
#pragma unroll 1
            for (int k = 0; S.S.next(k, uu); ++k) { S.k = k; pg8::Unit nx; E.mode = (k & 1) ? 2 : (S.S.next(k + 1, nx) ? 1 : 0);
                pg8::gemm_phase<pg8::EpiRoute, pg8::OneUnit, false, true>(F.lds + RING_OFF, g, S, E); E.prev = uu; } }
#endif
        PHASE_END
        PHASE_BEGIN(pb + 5, 6)
#if EN_EXP
            if (layer == DEPTH - 1) phase_peer_expert<true>(F, args, layer, psc); else phase_peer_expert<false>(F, args, layer, psc);
#endif
        PHASE_END
    }
#undef PHASE_BEGIN
#undef PHASE_END
}
extern "C" void kernel_launch(void* const* d_in, const int* in_sizes, int n_in, void* d_out, int out_size, void* d_ws, size_t ws_size, hipStream_t stream) {
    static int grid = 0;
    if (grid == 0) {
        if (n_in != 25 || out_size != T * D || ws_size < WS_END) { fprintf(stderr, "kernel_launch: unexpected problem shape (n_in %d, out %d, ws %zu)\n", n_in, out_size, ws_size); grid = -1; return; }
        int dev = 0, cus = 0, per_cu = 0;
        if (hipGetDevice(&dev) != hipSuccess || hipDeviceGetAttribute(&cus, hipDeviceAttributeMultiprocessorCount, dev) != hipSuccess) { grid = -1; return; }
        if (hipFuncSetAttribute((const void*)mega_fwd, hipFuncAttributeMaxDynamicSharedMemorySize, LDS_BYTES) != hipSuccess) { fprintf(stderr, "kernel_launch: hipFuncSetAttribute failed\n"); grid = -1; return; }
        if (hipOccupancyMaxActiveBlocksPerMultiprocessor(&per_cu, (const void*)mega_fwd, NWAVES * 64, LDS_BYTES) != hipSuccess || per_cu < 1) fprintf(stderr, "kernel_launch: occupancy query says %d\n", per_cu);
        (void)hipGetLastError();
        grid = cus;
    }
    if (grid < 0) return;
    (void)hipMemsetAsync((char*)d_ws + WS_CTL, 0, CTL_ZERO_BYTES, stream);
    Args a{};
    for (int i = 0; i < 25; ++i) a.in[i] = (const float*)d_in[i];
    a.out = (float*)d_out; a.ws = (unsigned char*)d_ws;
    a.ph_lo = 0; a.ph_hi = N_PHASES; a.li = 0; a.pad = 0;
    hipLaunchKernelGGL(mega_fwd, dim3(grid), dim3(NWAVES * 64), LDS_BYTES, stream, a);
}
```
